# Optimizing an MI355X kernel written in HIP

```python
import math
import jax, jax.numpy as jnp
from jax import lax
import numpy as np

D_MODEL = 2048
BATCH = 16
SEQ = 2048
DEPTH = 1

D_MLSTM = D_MODEL // 2
N_MLSTM_HEADS = 4
DV_HEAD = D_MLSTM // N_MLSTM_HEADS
DQK_HEAD = DV_HEAD // 2
D_QK = N_MLSTM_HEADS * DQK_HEAD
MLSTM_CHUNK = 128
CONV_WIDTH = 4
D_GMLP = D_MODEL - D_MLSTM
N_GMLP_GROUPS = 8
GMLP_GROUP = D_GMLP // N_GMLP_GROUPS
SPATIAL_CHUNK = 128
D_FF = 5632
N_SUBLAYERS = 3
N_MOD = 3
EPS = 1e-6
D_IN = 2 * D_QK + 2 * D_MLSTM + 2 * N_MLSTM_HEADS + 2 * D_GMLP
SPLITS = tuple(np.cumsum([D_QK, D_QK, D_MLSTM, D_MLSTM, N_MLSTM_HEADS, N_MLSTM_HEADS, D_GMLP])[:].tolist())

kernel_name = "hymba_style_mlstm_gmlp_macaron_adaln"


def rms_norm(x, g):
    xf = x.astype(jnp.float32)
    y = xf * lax.rsqrt(jnp.mean(xf * xf, axis=-1, keepdims=True) + EPS)
    return (y * g.astype(jnp.float32)).astype(x.dtype)


def layer_norm(x, g, b):
    xf = x.astype(jnp.float32)
    mu = jnp.mean(xf, axis=-1, keepdims=True)
    var = jnp.mean(jnp.square(xf - mu), axis=-1, keepdims=True)
    y = (xf - mu) * lax.rsqrt(var + EPS)
    return (y * g.astype(jnp.float32) + b.astype(jnp.float32)).astype(x.dtype)


def causal_dwconv(x, w, b):
    s = x.shape[1]
    xp = jnp.pad(x, ((0, 0), (CONV_WIDTH - 1, 0), (0, 0)))
    y = sum(w[j] * xp[:, j:j + s] for j in range(CONV_WIDTH))
    return y + b


def swiglu(h, w_gate, w_up, w_down):
    return (jax.nn.silu(h @ w_gate) * (h @ w_up)) @ w_down


def mlstm_chunkwise(q, k, v, i_pre, f_pre):
    b_, s_, h_, _ = q.shape
    nc, L = s_ // MLSTM_CHUNK, MLSTM_CHUNK

    def to_chunks(t):
        return t.astype(jnp.float32).reshape(b_, nc, L, h_, t.shape[-1]).transpose(0, 3, 1, 2, 4)

    def gate_chunks(t):
        return t.astype(jnp.float32).reshape(b_, nc, L, h_).transpose(0, 3, 1, 2)

    qc, kc, vc = to_chunks(q), to_chunks(k), to_chunks(v)
    ig = gate_chunks(i_pre)
    logf = jax.nn.log_sigmoid(gate_chunks(f_pre))
    bcum = jnp.cumsum(logf, axis=-1)
    b_last = bcum[..., -1]

    causal = jnp.tril(jnp.ones((L, L), dtype=bool))
    dmat = jnp.where(causal, bcum[..., :, None] - bcum[..., None, :] + ig[..., None, :], -jnp.inf)
    m_intra = jnp.max(dmat, axis=-1)

    w_state = b_last[..., None] - bcum + ig
    m_loc = jnp.max(w_state, axis=-1)
    e_state = jnp.exp(w_state - m_loc[..., None])
    c_inc = jnp.einsum('bhnl,bhnle,bhnld->bhned', e_state, vc, kc)
    n_inc = jnp.einsum('bhnl,bhnld->bhnd', e_state, kc)

    def step(carry, xs):
        c_st, n_st, m_st = carry
        c_x, n_x, m_x, b_x = xs
        m_new = jnp.maximum(b_x + m_st, m_x)
        a = jnp.exp(b_x + m_st - m_new)
        s = jnp.exp(m_x - m_new)
        c_new = a[..., None, None] * c_st + s[..., None, None] * c_x
        n_new = a[..., None] * n_st + s[..., None] * n_x
        return (c_new, n_new, m_new), (c_st, n_st, m_st)

    init = (jnp.zeros((b_, h_, DV_HEAD, DQK_HEAD), jnp.float32),
            jnp.zeros((b_, h_, DQK_HEAD), jnp.float32),
            jnp.zeros((b_, h_), jnp.float32))
    xs = (jnp.moveaxis(c_inc, 2, 0), jnp.moveaxis(n_inc, 2, 0),
          jnp.moveaxis(m_loc, 2, 0), jnp.moveaxis(b_last, 2, 0))
    _, (c_prev, n_prev, m_prev) = lax.scan(step, init, xs)
    c_prev = jnp.moveaxis(c_prev, 0, 2)
    n_prev = jnp.moveaxis(n_prev, 0, 2)
    m_prev = jnp.moveaxis(m_prev, 0, 2)

    m_inter = bcum + m_prev[..., None]
    m_t = jnp.maximum(m_inter, m_intra)
    inter_scale = jnp.exp(m_inter - m_t)
    p = jnp.exp(dmat - m_t[..., None])
    s_qk = jnp.einsum('bhnld,bhnsd->bhnls', qc, kc) * p
    num = (inter_scale[..., None] * jnp.einsum('bhnld,bhned->bhnle', qc, c_prev)
           + jnp.einsum('bhnls,bhnse->bhnle', s_qk, vc))
    den = inter_scale * jnp.einsum('bhnld,bhnd->bhnl', qc, n_prev) + jnp.sum(s_qk, axis=-1)
    hc = num / jnp.maximum(jnp.abs(den), jnp.exp(-m_t))[..., None]
    return hc.transpose(0, 2, 3, 1, 4).reshape(b_, s_, h_, DV_HEAD)


def spatial_gating(u, v, ln_g, ln_b, w_sp, b_sp):
    b_, s_, _ = v.shape
    nc, L = s_ // SPATIAL_CHUNK, SPATIAL_CHUNK
    v = layer_norm(v, ln_g, ln_b).reshape(b_, nc, L, N_GMLP_GROUPS, GMLP_GROUP)
    w_causal = w_sp * jnp.tril(jnp.ones((L, L), dtype=w_sp.dtype))
    z = jnp.einsum('gts,bnsgc->bntgc', w_causal, v) + b_sp.T[None, None, :, :, None]
    return u * z.reshape(b_, s_, D_GMLP)


def setup_inputs(seed: int = 0) -> dict:
    key = jax.random.key(seed)
    ks = jax.random.split(key, 24)
    f32 = jnp.float32
    nrm = lambda k, shape, scale: jax.random.normal(k, shape, f32) * scale
    return {
        "x": nrm(ks[0], (BATCH, SEQ, D_MODEL), 1.0),
        "c": nrm(ks[1], (BATCH, D_MODEL), 1.0),
        "w_ada": nrm(ks[2], (DEPTH, D_MODEL, N_SUBLAYERS * N_MOD * D_MODEL), 0.5 * D_MODEL ** -0.5),
        "b_ada": nrm(ks[3], (DEPTH, N_SUBLAYERS * N_MOD * D_MODEL), 0.01),
        "g_pre": 1.0 + nrm(ks[4], (DEPTH, N_SUBLAYERS, D_MODEL), 0.05),
        "g_post": 1.0 + nrm(ks[5], (DEPTH, N_SUBLAYERS, D_MODEL), 0.05),
        "w_ff_gate": nrm(ks[6], (DEPTH, 2, D_MODEL, D_FF), D_MODEL ** -0.5),
        "w_ff_up": nrm(ks[7], (DEPTH, 2, D_MODEL, D_FF), D_MODEL ** -0.5),
        "w_ff_down": nrm(ks[8], (DEPTH, 2, D_FF, D_MODEL), D_FF ** -0.5),
        "w_in": nrm(ks[9], (DEPTH, D_MODEL, D_IN), D_MODEL ** -0.5),
        "conv_w": nrm(ks[10], (DEPTH, CONV_WIDTH, 2 * D_QK), CONV_WIDTH ** -0.5),
        "conv_b": nrm(ks[11], (DEPTH, 2 * D_QK), 0.01),
        "b_igate": nrm(ks[12], (DEPTH, N_MLSTM_HEADS), 0.1),
        "b_fgate": jnp.linspace(3.0, 6.0, N_MLSTM_HEADS, dtype=f32)[None, :] + nrm(ks[13], (DEPTH, N_MLSTM_HEADS), 0.1),
        "g_mhnorm": 1.0 + nrm(ks[14], (DEPTH, N_MLSTM_HEADS, DV_HEAD), 0.05),
        "gmlp_ln_g": 1.0 + nrm(ks[15], (DEPTH, D_GMLP), 0.05),
        "gmlp_ln_b": nrm(ks[16], (DEPTH, D_GMLP), 0.01),
        "w_spatial": nrm(ks[17], (DEPTH, N_GMLP_GROUPS, SPATIAL_CHUNK, SPATIAL_CHUNK), SPATIAL_CHUNK ** -0.5),
        "b_spatial": 1.0 + nrm(ks[18], (DEPTH, N_GMLP_GROUPS, SPATIAL_CHUNK), 0.05),
        "w_out": nrm(ks[19], (DEPTH, D_MODEL, D_MODEL), D_MODEL ** -0.5),
    }


def reference(x, c, w_ada, b_ada, g_pre, g_post, w_ff_gate, w_ff_up, w_ff_down, w_in, conv_w, conv_b,
              b_igate, b_fgate, g_mhnorm, gmlp_ln_g, gmlp_ln_b, w_spatial, b_spatial, w_out):
    b_, s_, _ = x.shape
    for l in range(DEPTH):
        mod = (jax.nn.silu(c) @ w_ada[l] + b_ada[l]).reshape(b_, N_SUBLAYERS, N_MOD, D_MODEL)

        def sublayer(x_res, j, fn, coef):
            shift, scale, gate = mod[:, j, 0], mod[:, j, 1], mod[:, j, 2]
            h = rms_norm(x_res, g_pre[l, j]) * (1.0 + scale[:, None, :]) + shift[:, None, :]
            y = rms_norm(fn(h), g_post[l, j])
            return x_res + coef * gate[:, None, :] * y

        def ffn(idx):
            return lambda h: swiglu(h, w_ff_gate[l, idx], w_ff_up[l, idx], w_ff_down[l, idx])

        def mixer(h):
            proj = h @ w_in[l]
            q, k, v, o, ig, fg, u, gv = jnp.split(proj, SPLITS, axis=-1)
            qk = jax.nn.silu(causal_dwconv(jnp.concatenate([q, k], axis=-1), conv_w[l], conv_b[l]))
            q, k = qk[..., :D_QK], qk[..., D_QK:]
            q = q.reshape(b_, s_, N_MLSTM_HEADS, DQK_HEAD)
            k = k.reshape(b_, s_, N_MLSTM_HEADS, DQK_HEAD) * (DQK_HEAD ** -0.5)
            v = v.reshape(b_, s_, N_MLSTM_HEADS, DV_HEAD)
            hm = mlstm_chunkwise(q, k, v, ig + b_igate[l], fg + b_fgate[l])
            hm = rms_norm(hm, g_mhnorm[l]).astype(x.dtype).reshape(b_, s_, D_MLSTM)
            hm = jax.nn.sigmoid(o) * hm
            z = spatial_gating(jax.nn.gelu(u), jax.nn.gelu(gv), gmlp_ln_g[l], gmlp_ln_b[l],
                               w_spatial[l], b_spatial[l])
            return jnp.concatenate([hm, z], axis=-1) @ w_out[l]

        x = sublayer(x, 0, ffn(0), 0.5)
        x = sublayer(x, 1, mixer, 1.0)
        x = sublayer(x, 2, ffn(1), 0.5)
    return x
```

```cpp
#include <hip/hip_runtime.h>
#include <hip/hip_cooperative_groups.h>
#include <cstdio>
#include <cstdint>
namespace cg = cooperative_groups;
namespace pg8 {
#define PG8_LAS __attribute__((address_space(3)))
typedef unsigned short bf16_t;
typedef short bf16x8 __attribute__((ext_vector_type(8)));
typedef float f32x4 __attribute__((ext_vector_type(4)));
typedef unsigned u32x4 __attribute__((ext_vector_type(4)));
constexpr int BM = 256, BK = 64, HALF = 128, HTB = HALF * BK * 2  , STAGE_BYTES = 8 * HTB, NXCD = 8, WGM = 8;

__host__ __device__ __forceinline__ int lds_byte(int r, int c) { const int st = (r >> 4) * 2 + (c >> 5), rr = r & 15, cc = c & 31, ob = rr * 64 + cc * 2; return st * 1024 + (ob ^ (((ob >> 9) & 1) << 5)); }
__host__ __device__ __forceinline__ void stage_rc(int b, int& R, int& C) { const int st = b / 1024, sb = b % 1024, swz = sb ^ (((sb >> 9) & 1) << 5); R = (st >> 1) * 16 + swz / 64; C = (st & 1) * 32 + (swz % 64) / 2; }
__host__ __device__ __forceinline__ int perm32(int rho) { const int n = rho >> 4, i = rho & 15; return 8 * (i >> 2) + 4 * n + (i & 3); }

struct Unit { int pm, pn; };
struct Gemm { const bf16_t* A; const bf16_t* Bt; int M, N, K; };

struct StaticOrder {
    int nM, nN, nwg, G, c;
    __host__ __device__ void init(int M, int N, int G_, int c_) { nM = M / BM; nN = N / BM; nwg = nM * nN; G = G_; c = c_; }
    __host__ __device__ bool next(int i, Unit& u) const {
        const long L = (long)i * G + c; if (L >= nwg) return false;
        int wgid = (int)L; { const int q = nwg / NXCD, r = nwg % NXCD, xcd = wgid % NXCD, off = wgid / NXCD; wgid = (xcd < r ? xcd * (q + 1) : r * (q + 1) + (xcd - r) * q) + off; }
        const int nig = WGM * nN, gid = wgid / nig, fm = gid * WGM, gsz = (nM - fm) < WGM ? (nM - fm) : WGM;
        u.pm = fm + ((wgid % nig) % gsz); u.pn = (wgid % nig) / gsz; return true;
    }
    __device__ __forceinline__ void a_ready(const Unit&) const {}
    __device__ __forceinline__ void done(const Unit&) const {}
};
__device__ __forceinline__ unsigned cvt_pk_bf16(float lo, float hi) { unsigned r; asm volatile("v_cvt_pk_bf16_f32 %0, %1, %2" : "=v"(r) : "v"(lo), "v"(hi)); return r; }
typedef unsigned u32x2 __attribute__((ext_vector_type(2)));
__device__ __forceinline__ float fast_sigmoid(float v) { return __builtin_amdgcn_rcpf(1.0f + __builtin_amdgcn_exp2f(-1.44269504f * v)); }
__device__ __forceinline__ float silu_f(float v) { return v * fast_sigmoid(v); }
__device__ __forceinline__ float gelu_tanh_f(float v) { const float u = 1.59576912f * (v + 0.044715f * v * v * v); return v * fast_sigmoid(u); }

struct EpiSwiglu {
    static constexpr bool PERM = true, AFTER_DRAIN = false; static constexpr int NST = 8;
    bf16_t* O; int ldc;
    __device__ __forceinline__ void operator()(const f32x4 (&acc)[2][2][4][2], const Unit& u, int wr, int wc, int fr, int fq) const {
        const int row0 = u.pm * BM + wr * 64 + fr, col0 = u.pn * HALF + wc * 32 + 8 * fq;
#pragma unroll
        for (int ai = 0; ai < 2; ++ai)
#pragma unroll
            for (int m = 0; m < 4; ++m) {
                bf16_t* rowp = O + (size_t)(row0 + ai * HALF + m * 16) * ldc + col0;
                const f32x4 g0 = acc[ai][0][m][0], g1 = acc[ai][0][m][1], u0 = acc[ai][1][m][0], u1 = acc[ai][1][m][1];
                u32x4 w;
                w.x = cvt_pk_bf16(silu_f(g0[0]) * u0[0], silu_f(g0[1]) * u0[1]); w.y = cvt_pk_bf16(silu_f(g0[2]) * u0[2], silu_f(g0[3]) * u0[3]);
                w.z = cvt_pk_bf16(silu_f(g1[0]) * u1[0], silu_f(g1[1]) * u1[1]); w.w = cvt_pk_bf16(silu_f(g1[2]) * u1[2], silu_f(g1[3]) * u1[3]);
                *(u32x4*)rowp = w;
            }
    }
};
struct EpiYStat {
    static constexpr bool PERM = true, AFTER_DRAIN = false; static constexpr int NST = 24;
    bf16_t* Y; int ldc; float* ssq;
    __device__ __forceinline__ void operator()(const f32x4 (&acc)[2][2][4][2], const Unit& u, int wr, int wc, int fr, int fq) const {
        const int row0 = u.pm * BM + wr * 64 + fr, col0 = u.pn * BM + wc * 32 + 8 * fq;
#pragma unroll
        for (int ai = 0; ai < 2; ++ai)
#pragma unroll
            for (int m = 0; m < 4; ++m) {
                const int row = row0 + ai * HALF + m * 16;
                bf16_t* rowp = Y + (size_t)row * ldc + col0;
                float s = 0.f;
#pragma unroll
                for (int bj = 0; bj < 2; ++bj) {
                    const f32x4 v0 = acc[ai][bj][m][0], v1 = acc[ai][bj][m][1];
                    s += (v0[0] * v0[0] + v0[1] * v0[1]) + (v0[2] * v0[2] + v0[3] * v0[3]) + (v1[0] * v1[0] + v1[1] * v1[1]) + (v1[2] * v1[2] + v1[3] * v1[3]);
                    u32x4 w; w.x = cvt_pk_bf16(v0[0], v0[1]); w.y = cvt_pk_bf16(v0[2], v0[3]); w.z = cvt_pk_bf16(v1[0], v1[1]); w.w = cvt_pk_bf16(v1[2], v1[3]);
                    *(u32x4*)(rowp + bj * HALF) = w;
                }
                s += __shfl_xor(s, 16); s += __shfl_xor(s, 32);
                if (fq == 0) ssq[(size_t)row * 32 + u.pn * 4 + wc] = s;
            }
    }
};
struct EpiProj {
    static constexpr bool PERM = true, AFTER_DRAIN = false; static constexpr int NST = 16;
    bf16_t* P; int ldc; float* gvstat; float* G; const float* b_i; const float* b_f;
    __device__ __forceinline__ void operator()(const f32x4 (&acc)[2][2][4][2], const Unit& u, int wr, int wc, int fr, int fq) const {
        const int pn = u.pn;
        const int row0 = u.pm * BM + wr * 64 + fr;
        if (pn == 20) {
            if (wc == 0 && fq == 0) {
                const f32x4 bi = *(const f32x4*)b_i, bf = *(const f32x4*)b_f;
#pragma unroll
                for (int ai = 0; ai < 2; ++ai)
#pragma unroll
                    for (int m = 0; m < 4; ++m) {
                        const int row = row0 + ai * HALF + m * 16;
                        *(f32x4*)(G + (size_t)row * 8) = acc[ai][0][m][0] + bi;
                        *(f32x4*)(G + (size_t)row * 8 + 4) = acc[ai][0][m][1] + bf;
                    }
            }
            return;
        }
        const int mode = pn < 8 ? 0 : (pn < 12 ? 1 : (pn < 16 ? 2 : 3));
        const int col0 = pn * BM + wc * 32 + 8 * fq;
#pragma unroll
        for (int ai = 0; ai < 2; ++ai)
#pragma unroll
            for (int m = 0; m < 4; ++m) {
                const int row = row0 + ai * HALF + m * 16;
                bf16_t* rowp = P + (size_t)row * ldc + col0;
                float s1 = 0.f, s2 = 0.f;
#pragma unroll
                for (int bj = 0; bj < 2; ++bj) {
                    f32x4 v0 = acc[ai][bj][m][0], v1 = acc[ai][bj][m][1];
                    if (mode == 1) {
#pragma unroll
                        for (int j = 0; j < 4; ++j) { v0[j] = fast_sigmoid(v0[j]); v1[j] = fast_sigmoid(v1[j]); }
                    } else if (mode >= 2) {
#pragma unroll
                        for (int j = 0; j < 4; ++j) { v0[j] = gelu_tanh_f(v0[j]); v1[j] = gelu_tanh_f(v1[j]); }
                    }
                    s1 += (v0[0] + v0[1]) + (v0[2] + v0[3]) + (v1[0] + v1[1]) + (v1[2] + v1[3]);
                    s2 += (v0[0] * v0[0] + v0[1] * v0[1]) + (v0[2] * v0[2] + v0[3] * v0[3]) + (v1[0] * v1[0] + v1[1] * v1[1]) + (v1[2] * v1[2] + v1[3] * v1[3]);
                    u32x4 w; w.x = cvt_pk_bf16(v0[0], v0[1]); w.y = cvt_pk_bf16(v0[2], v0[3]); w.z = cvt_pk_bf16(v1[0], v1[1]); w.w = cvt_pk_bf16(v1[2], v1[3]);
                    *(u32x4*)(rowp + bj * HALF) = w;
                }
                if (mode == 3) {
                    s1 += __shfl_xor(s1, 16); s1 += __shfl_xor(s1, 32); s2 += __shfl_xor(s2, 16); s2 += __shfl_xor(s2, 32);
                    if (fq == 0) { float* gp = gvstat + ((size_t)row * 16 + (pn - 16) * 4 + wc) * 2; gp[0] = s1; gp[1] = s2; }
                }
            }
    }
};
template <class Epi, class Sched, bool ALIGN_EPI = false, bool SP2 = false>
__device__ __forceinline__ void gemm_phase(PG8_LAS unsigned char* lds, const Gemm g, const Sched& S, const Epi& E) {
    int tid_l = threadIdx.x; asm volatile("" : "+v"(tid_l));
    int K_l = g.K; asm volatile("" : "+s"(K_l));
    const int tid = tid_l, wid = __builtin_amdgcn_readfirstlane(tid >> 6), lane = tid & 63, wr = wid >> 2, wc = wid & 3, fr = lane & 15, fq = lane >> 4;
    const int K = K_l, nt = K / BK;
    unsigned voffA[2], voffB[2];
#pragma unroll
    for (int i = 0; i < 2; ++i) { int R, C; stage_rc(tid * 16 + i * 8192, R, C); const int Rb = Epi::PERM ? ((R & ~31) + perm32(R & 31)) : R;
        voffA[i] = (unsigned)(R * K + C) * 2u; voffB[i] = (unsigned)(Rb * K + C) * 2u; }
    const size_t kstep = (size_t)(BK * 2);
    const size_t hstep = (size_t)HALF * K * 2;
    const size_t tstep = 2 * hstep;
    const unsigned ldsw = (unsigned)wid * 1024u;
    const int aoff = lds_byte(wr * 64 + fr, fq * 8), boff = lds_byte(wc * 32 + fr, fq * 8);
#define PG8_SA(b, h) (((b) * 2 + (h)) * HTB)
#define PG8_SB(b, h) ((4 + (b) * 2 + (h)) * HTB)
#define PG8_STAGE(bufoff, gbase, voff) do { _Pragma("unroll") for (int _i = 0; _i < 2; ++_i) \
        __builtin_amdgcn_global_load_lds((const unsigned*)((const char*)(gbase) + (voff)[_i]), (PG8_LAS unsigned*)(lds + (bufoff) + ldsw + _i * 8192), 16, 0, 0); } while (0)
#define PG8_LDA(dst, b, h) do { _Pragma("unroll") for (int m = 0; m < 4; ++m) _Pragma("unroll") for (int k = 0; k < 2; ++k) dst[m][k] = *(const PG8_LAS bf16x8*)(lds + PG8_SA(b, h) + aoff + m * 2048 + k * 1024); } while (0)
#define PG8_LDB(dst, b, h) do { _Pragma("unroll") for (int n = 0; n < 2; ++n) _Pragma("unroll") for (int k = 0; k < 2; ++k) dst[n][k] = *(const PG8_LAS bf16x8*)(lds + PG8_SB(b, h) + boff + n * 2048 + k * 1024); } while (0)
#define PG8_MMA(ai, bj, At, Bt) do { __builtin_amdgcn_s_setprio(1); _Pragma("unroll") for (int m = 0; m < 4; ++m) _Pragma("unroll") for (int n = 0; n < 2; ++n) _Pragma("unroll") for (int k = 0; k < 2; ++k) \
        acc[ai][bj][m][n] = __builtin_amdgcn_mfma_f32_16x16x32_bf16(Bt[n][k], At[m][k], acc[ai][bj][m][n], 0, 0, 0); __builtin_amdgcn_s_setprio(0); } while (0)
#define PG8_WAIT_V(n) asm volatile("s_waitcnt vmcnt(" #n ")" ::: "memory")
#define PG8_WAIT_L(n) asm volatile("s_waitcnt lgkmcnt(" #n ")" ::: "memory")
#define PG8_BAR __builtin_amdgcn_s_barrier()
#define PG8_SCHED __builtin_amdgcn_sched_barrier(0)
    Unit cur, nxt; int ui = 0;
    if (!S.next(0, cur)) return;
    f32x4 acc[2][2][4][2];
#pragma unroll
    for (int a = 0; a < 2; ++a)
#pragma unroll
        for (int b = 0; b < 2; ++b)
#pragma unroll
            for (int m = 0; m < 4; ++m)
#pragma unroll
                for (int n = 0; n < 2; ++n) acc[a][b][m][n] = (f32x4){0.f, 0.f, 0.f, 0.f};
    bf16x8 At[4][2], B0[2][2], B1[2][2];
    const char* cA = (const char*)g.A + (size_t)cur.pm * tstep; const char* cB = (const char*)g.Bt + (size_t)cur.pn * tstep;
    S.a_ready(cur);
    if constexpr (SP2) {
        PG8_STAGE(PG8_SB(0, 0), cB, voffB); PG8_STAGE(PG8_SB(0, 1), cB + hstep, voffB); PG8_STAGE(PG8_SA(0, 0), cA, voffA); PG8_STAGE(PG8_SA(0, 1), cA + hstep, voffA);
        if (wr == 1) PG8_BAR;
        PG8_WAIT_V(2); PG8_BAR;
        PG8_STAGE(PG8_SB(1, 0), cB + kstep, voffB); PG8_STAGE(PG8_SA(1, 0), cA + kstep, voffA); PG8_STAGE(PG8_SB(1, 1), cB + hstep + kstep, voffB);
        PG8_WAIT_V(6); PG8_BAR;
    } else {
        PG8_STAGE(PG8_SB(0, 0), cB, voffB); PG8_STAGE(PG8_SA(0, 0), cA, voffA); PG8_STAGE(PG8_SB(0, 1), cB + hstep, voffB); PG8_STAGE(PG8_SA(0, 1), cA + hstep, voffA);
        if (wr == 1) PG8_BAR;
        PG8_WAIT_V(4); PG8_BAR;
        PG8_STAGE(PG8_SB(1, 0), cB + kstep, voffB); PG8_STAGE(PG8_SA(1, 0), cA + kstep, voffA); PG8_STAGE(PG8_SB(1, 1), cB + hstep + kstep, voffB);
        PG8_WAIT_V(6); PG8_BAR;
    }
    for (;;) {
        const bool has_next = S.next(ui + 1, nxt);
        const char* nA = has_next ? (const char*)g.A + (size_t)nxt.pm * tstep : cA; const char* nB = has_next ? (const char*)g.Bt + (size_t)nxt.pn * tstep : cB;
        for (int t = 0; t < nt; t += 2) {
            const bool last = (t == nt - 2);
            const char* a1 = cA + (size_t)(t + 1) * kstep;
            const char* a2 = last ? nA : cA + (size_t)(t + 2) * kstep; const char* b2 = last ? nB : cB + (size_t)(t + 2) * kstep;
            const char* a3 = a2 + kstep; const char* b3 = b2 + kstep;
            if (last && has_next) S.a_ready(nxt);
            if constexpr (SP2) {
            PG8_LDB(B0, 0, 0); PG8_LDB(B1, 0, 1); PG8_SCHED; PG8_LDA(At, 0, 0); PG8_STAGE(PG8_SA(1, 1), a1 + hstep, voffA);
            PG8_WAIT_V(8); PG8_WAIT_L(0); PG8_BAR; PG8_MMA(0, 0, At, B0); PG8_MMA(0, 1, At, B1); PG8_BAR; PG8_SCHED;
            PG8_LDA(At, 0, 1); PG8_STAGE(PG8_SB(0, 0), b2, voffB); PG8_STAGE(PG8_SB(0, 1), b2 + hstep, voffB); PG8_STAGE(PG8_SA(0, 0), a2, voffA);
            PG8_WAIT_V(8); PG8_WAIT_L(0); PG8_BAR; PG8_MMA(1, 0, At, B0); PG8_MMA(1, 1, At, B1); PG8_BAR; PG8_SCHED;
            PG8_LDB(B0, 1, 0); PG8_LDB(B1, 1, 1); PG8_SCHED; PG8_LDA(At, 1, 0); PG8_STAGE(PG8_SA(0, 1), a2 + hstep, voffA);
            PG8_WAIT_V(8); PG8_WAIT_L(0); PG8_BAR; PG8_MMA(0, 0, At, B0); PG8_MMA(0, 1, At, B1); PG8_BAR; PG8_SCHED;
            PG8_LDA(At, 1, 1); PG8_STAGE(PG8_SB(1, 0), b3, voffB); PG8_STAGE(PG8_SB(1, 1), b3 + hstep, voffB); PG8_STAGE(PG8_SA(1, 0), a3, voffA);
            PG8_WAIT_V(8); PG8_WAIT_L(0); PG8_BAR; PG8_MMA(1, 0, At, B0); PG8_MMA(1, 1, At, B1); PG8_BAR; PG8_SCHED;
            } else {
            PG8_LDB(B0, 0, 0); PG8_SCHED; PG8_LDA(At, 0, 0); PG8_STAGE(PG8_SA(1, 1), a1 + hstep, voffA);
            PG8_WAIT_L(8); PG8_BAR; PG8_WAIT_L(0); PG8_MMA(0, 0, At, B0); PG8_BAR; PG8_SCHED;
            PG8_LDB(B1, 0, 1); PG8_STAGE(PG8_SB(0, 0), b2, voffB);
            PG8_BAR; PG8_WAIT_L(0); PG8_MMA(0, 1, At, B1); PG8_BAR;
            PG8_LDA(At, 0, 1); PG8_STAGE(PG8_SA(0, 0), a2, voffA);
            PG8_BAR; PG8_WAIT_L(0); PG8_MMA(1, 0, At, B0); PG8_BAR; PG8_SCHED;
            PG8_STAGE(PG8_SB(0, 1), b2 + hstep, voffB);
            PG8_WAIT_V(6); PG8_BAR; PG8_MMA(1, 1, At, B1); PG8_BAR;
            PG8_LDB(B0, 1, 0); PG8_SCHED; PG8_LDA(At, 1, 0); PG8_STAGE(PG8_SA(0, 1), a2 + hstep, voffA);
            PG8_WAIT_L(8); PG8_BAR; PG8_WAIT_L(0); PG8_MMA(0, 0, At, B0); PG8_BAR; PG8_SCHED;
            PG8_LDB(B1, 1, 1); PG8_STAGE(PG8_SB(1, 0), b3, voffB);
            PG8_BAR; PG8_WAIT_L(0); PG8_MMA(0, 1, At, B1); PG8_BAR;
            PG8_LDA(At, 1, 1); PG8_STAGE(PG8_SA(1, 0), a3, voffA);
            PG8_BAR; PG8_WAIT_L(0); PG8_MMA(1, 0, At, B0); PG8_BAR; PG8_SCHED;
            PG8_STAGE(PG8_SB(1, 1), b3 + hstep, voffB);
            PG8_WAIT_V(6); PG8_BAR; PG8_MMA(1, 1, At, B1); PG8_BAR;
            }
        }
        if constexpr (ALIGN_EPI) { if (wr == 0) PG8_BAR; }
        if constexpr (!Epi::AFTER_DRAIN) { E(acc, cur, wr, wc, fr, fq); S.done(cur); }
        if (!has_next) break;
#pragma unroll
        for (int a = 0; a < 2; ++a)
#pragma unroll
            for (int b = 0; b < 2; ++b)
#pragma unroll
                for (int m = 0; m < 4; ++m)
#pragma unroll
                    for (int n = 0; n < 2; ++n) acc[a][b][m][n] = (f32x4){0.f, 0.f, 0.f, 0.f};
        cur = nxt; cA = nA; cB = nB; ++ui;
        if constexpr (ALIGN_EPI) { if (wr == 1) PG8_BAR; }
    }
    PG8_WAIT_V(0);
    if constexpr (!ALIGN_EPI) { if (wr == 0) PG8_BAR; }
    PG8_BAR;
    if constexpr (Epi::AFTER_DRAIN) { E.fused(acc, cur, wr, wc, fr, fq, lds, wid, lane); S.done(cur); }
#undef PG8_SA
#undef PG8_SB
#undef PG8_STAGE
#undef PG8_LDA
#undef PG8_LDB
#undef PG8_MMA
#undef PG8_WAIT_V
#undef PG8_WAIT_L
#undef PG8_BAR
#undef PG8_SCHED
}
}

#define LAS __attribute__((address_space(3)))
typedef unsigned short bf16;
typedef float f32x4 __attribute__((ext_vector_type(4)));
typedef float f32x2 __attribute__((ext_vector_type(2)));
typedef unsigned u32x4 __attribute__((ext_vector_type(4)));
typedef unsigned u32x2 __attribute__((ext_vector_type(2)));
typedef short bf16x8 __attribute__((ext_vector_type(8)));

constexpr int NB = 16, SEQ = 2048, D = 2048, T = NB * SEQ, DFF = 5632, NMOD = 9 * D;
constexpr int NPROJ = 5120, NIN = 5128, NIN_PAD = 5376, NGU = 2 * DFF;
constexpr float EPS = 1e-6f;
constexpr size_t MiB = 1u << 20;
constexpr size_t OFF_H0A = 256 * 1024, OFF_H0 = 512 * 1024, OFF_S00 = 768 * 1024;
constexpr size_t OFF_GX = 2304 * 1024, OFF_UX = 2688 * 1024, OFF_YP = 3072 * 1024;
constexpr size_t OFF_MOD = 1 * MiB, OFF_YSSQ = 4 * MiB, OFF_GVSTAT = 8 * MiB, OFF_HSSQ = 12 * MiB, OFF_G = 14 * MiB;
constexpr size_t OFF_WGU0 = 16 * MiB, OFF_WD0 = 60 * MiB, OFF_WGU1 = 82 * MiB, OFF_WD1 = 126 * MiB, OFF_WIN = 148 * MiB, OFF_WOUT = 169 * MiB;
constexpr size_t OFF_H = 192 * MiB, OFF_Y = 320 * MiB, OFF_ACT = 448 * MiB, WS_END = 800 * MiB;
constexpr int LDS_BYTES = 155648;
constexpr int LDP = 136;

__device__ __forceinline__ unsigned short f2bf(float f) { unsigned u = __float_as_uint(f); return (unsigned short)((u + 0x7fffu + ((u >> 16) & 1u)) >> 16); }
__device__ __forceinline__ unsigned pk2(float lo, float hi) { return pg8::cvt_pk_bf16(lo, hi); }
__device__ __forceinline__ float bflo(unsigned w) { return __uint_as_float(w << 16); }
__device__ __forceinline__ float bfhi(unsigned w) { return __uint_as_float(w & 0xffff0000u); }
__device__ __forceinline__ float wave_sum(float v) {
#pragma unroll
    for (int o = 1; o < 64; o <<= 1) v += __shfl_xor(v, o);
    return v;
}
#define LDS_WAIT() asm volatile("s_waitcnt lgkmcnt(0)" ::: "memory")
__device__ __forceinline__ bf16x8 frag(const LAS unsigned char* base, int row, int kcol) { return *(const LAS bf16x8*)(base + (row * LDP + kcol) * 2); }
#define MFMA16(a, b, c) __builtin_amdgcn_mfma_f32_16x16x32_bf16((a), (b), (c), 0, 0, 0)

__device__ __forceinline__ void transpose_item(const float* __restrict__ W, int N, int k0, int src4, bf16* __restrict__ WT, int K, int dstrow0, LAS float* scr, int lane) {
    const int lr = lane >> 4, c4 = lane & 15;
#pragma unroll
    for (int i = 0; i < 16; ++i) { const int kk = 4 * i + lr;
        const f32x4 v = src4 >= 0 ? __builtin_nontemporal_load((const f32x4*)(W + (size_t)(k0 + kk) * N + src4)) : (f32x4){0.f, 0.f, 0.f, 0.f};
        LAS float* d = scr + kk * 65 + 4 * c4; d[0] = v[0]; d[1] = v[1]; d[2] = v[2]; d[3] = v[3]; }
    LDS_WAIT();
    const int c = lane & 7;
#pragma unroll
    for (int j = 0; j < 8; ++j) { const int n = (lane >> 3) + 8 * j; const LAS float* sp = scr + (8 * c) * 65 + n;
        u32x4 o; o.x = pk2(sp[0 * 65], sp[1 * 65]); o.y = pk2(sp[2 * 65], sp[3 * 65]); o.z = pk2(sp[4 * 65], sp[5 * 65]); o.w = pk2(sp[6 * 65], sp[7 * 65]);
        *(u32x4*)(WT + (size_t)(dstrow0 + n) * K + k0 + 8 * c) = o; }
    LDS_WAIT();
}
__device__ __forceinline__ void p0_transposes(const float* const* in, unsigned char* ws, LAS unsigned char* lds, int blk, int nblk, int wid, int lane) {
    LAS float* scr = (LAS float*)(lds + wid * 16640);
    constexpr int IT_FF = 32 * 88, IT_IN = 32 * (NIN_PAD / 64), IT_OUT = 32 * 32, NITEMS = 6 * IT_FF + IT_IN + IT_OUT;
    int ibeg, iend;
    if (nblk == 256) { constexpr int N1 = 70, BASE = 144 * N1, REM = NITEMS - BASE;
        if (blk < 144) { ibeg = blk * N1; iend = ibeg + N1; } else { ibeg = BASE + (int)(((long)(blk - 144) * REM) / 112); iend = BASE + (int)(((long)(blk - 143) * REM) / 112); } }
    else { ibeg = (int)(((long)blk * NITEMS) / nblk); iend = (int)(((long)(blk + 1) * NITEMS) / nblk); }
    const int c4 = 4 * (lane & 15);
    for (int it = ibeg + wid; it < iend; it += 8) {
        if (it < 6 * IT_FF) {
            const int mat = it / IT_FF, r = it - mat * IT_FF, f = mat / 3, kind = mat - 3 * f;
            bf16* wgu = (bf16*)(ws + (f ? OFF_WGU1 : OFF_WGU0)); bf16* wd = (bf16*)(ws + (f ? OFF_WD1 : OFF_WD0));
            if (kind < 2) {
                const float* W = (kind == 0 ? in[6] : in[7]) + (size_t)f * D * DFF;
                const int kb = r / 88, nb = r - kb * 88, n0 = 64 * nb;
                transpose_item(W, DFF, 64 * kb, n0 + c4, wgu, D, 256 * (n0 >> 7) + (n0 & 127) + 128 * kind, scr, lane);
            } else {
                const float* W = in[8] + (size_t)f * DFF * D;
                const int kb = r >> 5, nb = r & 31;
                transpose_item(W, D, 64 * kb, 64 * nb + c4, wd, DFF, 64 * nb, scr, lane);
            }
        } else {
            int r = it - 6 * IT_FF;
            if (r < IT_IN) {
                const int nblk2 = NIN_PAD / 64, kb = r / nblk2, nb = r - kb * nblk2, d = 64 * nb + c4;
                const int src = d < 3072 ? d : (d < 5120 ? d + 8 : (d < 5128 ? d - 2048 : -1));
                transpose_item(in[9], NIN, 64 * kb, src, (bf16*)(ws + OFF_WIN), D, 64 * nb, scr, lane);
            } else {
                r -= IT_IN; const int kb = r >> 5, nb = r & 31;
                transpose_item(in[19], D, 64 * kb, 64 * nb + c4, (bf16*)(ws + OFF_WOUT), D, 64 * nb, scr, lane);
            }
        }
    }
}
template <int MODE, int CPL, int UNR>
__device__ __forceinline__ void gemv16_item(const float* __restrict__ A, const float* __restrict__ Bv, int lda, const float* __restrict__ W, int ldw, int n0, int cbeg, int cend,
                                            const float* __restrict__ bias, float* __restrict__ out, int ldo, LAS unsigned char* lds, int tid, int wid, int lane) {
    typedef float vt __attribute__((ext_vector_type(CPL)));
    constexpr int NC = 64 * CPL;
    LAS float* sw = (LAS float*)(lds + wid * 4096);
    LAS float* red = (LAS float*)(lds + 32768);
    vt acc[16];
#pragma unroll
    for (int b = 0; b < 16; ++b) acc[b] = (vt)(0.f);
    for (int c = cbeg + wid; c < cend; c += 8) {
        const int k0 = c * 64;
#pragma unroll
        for (int b = 0; b < 16; ++b) { const float v = A[(size_t)b * lda + k0 + lane]; float f;
            if (MODE == 0) f = v / (1.0f + __expf(-v)); else if (MODE == 1) f = v; else f = v / (1.0f + expf(-v)) * Bv[(size_t)b * lda + k0 + lane];
            sw[lane * 16 + b] = f; }
        LDS_WAIT();
#pragma unroll UNR
        for (int kk = 0; kk < 64; ++kk) {
            const vt wv = __builtin_nontemporal_load((const vt*)(W + (size_t)(k0 + kk) * ldw + n0 + CPL * lane));
            const LAS f32x4* sp = (const LAS f32x4*)(sw + kk * 16);
            const f32x4 s0 = sp[0], s1 = sp[1], s2 = sp[2], s3 = sp[3];
            acc[0] += wv * s0[0]; acc[1] += wv * s0[1]; acc[2] += wv * s0[2]; acc[3] += wv * s0[3];
            acc[4] += wv * s1[0]; acc[5] += wv * s1[1]; acc[6] += wv * s1[2]; acc[7] += wv * s1[3];
            acc[8] += wv * s2[0]; acc[9] += wv * s2[1]; acc[10] += wv * s2[2]; acc[11] += wv * s2[3];
            acc[12] += wv * s3[0]; acc[13] += wv * s3[1]; acc[14] += wv * s3[2]; acc[15] += wv * s3[3];
        }
        LDS_WAIT();
    }
#pragma unroll
    for (int b = 0; b < 16; ++b) *(LAS vt*)(red + (wid * 16 + b) * NC + CPL * lane) = acc[b];
    __syncthreads();
#pragma unroll
    for (int i = 0; i < 2 * CPL; ++i) { const int o = tid + 512 * i, b = o / NC, n = o % NC; float sacc = bias ? bias[n0 + n] : 0.f;
#pragma unroll
        for (int w = 0; w < 8; ++w) sacc += red[(w * 16 + b) * NC + n];
        out[(size_t)b * ldo + n0 + n] = sacc; }
    __syncthreads();
}

#ifndef EXACT_FFN0
#define EXACT_FFN0 0
#endif
__device__ __forceinline__ void row_pass(int k, const float* __restrict__ x, float* out, const bf16* __restrict__ Y, const float* __restrict__ yssq, const float* __restrict__ mod,
                                         const float* __restrict__ g_pre, const float* __restrict__ g_post, bf16* __restrict__ H, float* __restrict__ H0, float* __restrict__ H0A, const float* __restrict__ YP, LAS unsigned char* lds, int wid, int gw, int NGW, int lane) {
    int rbeg, rend, rstep;
    if ((NGW % NB) == 0 && (SEQ % (NGW / NB)) == 0) { const int wpb = NGW / NB, b0 = gw / wpb, wl = gw - b0 * wpb; rbeg = b0 * SEQ + wl; rend = (b0 + 1) * SEQ; rstep = wpb; }
    else { const int rpw = (T + NGW - 1) / NGW; rbeg = gw * rpw; rend = (rbeg + rpw < T) ? rbeg + rpw : T; rstep = 1; }
    if (rbeg >= rend) return;
    LAS f32x4* AVL = (LAS f32x4*)(lds + wid * 16384); LAS f32x4* SHL = (LAS f32x4*)(lds + wid * 16384 + 8192);
    const float* xin_base = (k <= 1) ? x : out;
    const int jj = k - 1;
    const float coef = (jj == 1) ? 1.0f : 0.5f;
    int cur_b = -1;
    f32x4 cg[8];
    f32x4 xn[8]; u32x2 yn[8]; float pn = 0.f;
#pragma unroll
    for (int i = 0; i < 8; ++i) { cg[i] = (f32x4){0.f, 0.f, 0.f, 0.f}; yn[i] = (u32x2){0u, 0u}; }
#define RP_LOAD(r_) do { _Pragma("unroll") for (int i = 0; i < 8; ++i) { const int d_ = 4 * (lane + 64 * i); \
        xn[i] = __builtin_nontemporal_load((const f32x4*)(xin_base + (size_t)(r_) * D + d_)); if (k > 0) yn[i] = __builtin_nontemporal_load((const u32x2*)(Y + (size_t)(r_) * D + d_)); } \
        if (k > 0) pn = lane < 32 ? yssq[(size_t)(r_) * 32 + lane] : 0.f; } while (0)
    RP_LOAD(rbeg);
    for (int r = rbeg; r < rend; r += rstep) {
        f32x4 xv[8]; u32x2 yw[8]; float p = pn;
#pragma unroll
        for (int i = 0; i < 8; ++i) { xv[i] = xn[i]; yw[i] = yn[i]; }
        if (r + rstep < rend) RP_LOAD(r + rstep);
        const int b = r >> 11;
        if (b != cur_b) {
            cur_b = b;
#pragma unroll
            for (int i = 0; i < 8; ++i) { const int d = 4 * (lane + 64 * i);
                if (k > 0) { const f32x4 gt = *(const f32x4*)(mod + (size_t)b * NMOD + (jj * 3 + 2) * D + d); const f32x4 gp = *(const f32x4*)(g_post + jj * D + d); cg[i] = gt * gp * coef; }
                if (k < 3) { const f32x4 gp = *(const f32x4*)(g_pre + k * D + d); const f32x4 sc = *(const f32x4*)(mod + (size_t)b * NMOD + (k * 3 + 1) * D + d);
                    AVL[lane + 64 * i] = gp * (sc + 1.0f); SHL[lane + 64 * i] = *(const f32x4*)(mod + (size_t)b * NMOD + (k * 3 + 0) * D + d); } }
            LDS_WAIT();
        }
        float ss = 0.f;
        if (EXACT_FFN0 && k == 1 && (r & (SEQ - 1)) == 0) {
            f32x4 ye[8]; float pe = 0.f;
#pragma unroll
            for (int i = 0; i < 8; ++i) { const int d = 4 * (lane + 64 * i); const float* yp = YP + (size_t)b * D + d;
                ye[i] = ((*(const f32x4*)yp + *(const f32x4*)(yp + 16 * D)) + (*(const f32x4*)(yp + 32 * D) + *(const f32x4*)(yp + 48 * D)))
                      + ((*(const f32x4*)(yp + 64 * D) + *(const f32x4*)(yp + 80 * D)) + (*(const f32x4*)(yp + 96 * D) + *(const f32x4*)(yp + 112 * D)));
                pe += (ye[i][0] * ye[i][0] + ye[i][1] * ye[i][1]) + (ye[i][2] * ye[i][2] + ye[i][3] * ye[i][3]); }
            pe = wave_sum(pe); const float rstd_y = 1.0f / sqrtf(pe * (1.0f / D) + EPS);
#pragma unroll
            for (int i = 0; i < 8; ++i) { const int d = 4 * (lane + 64 * i);
                const f32x4 v = xv[i] + cg[i] * rstd_y * ye[i];
                __builtin_nontemporal_store(v, (f32x4*)(out + (size_t)r * D + d)); xv[i] = v; }
        } else if (k > 0) {
            p = wave_sum(p); const float rstd_y = 1.0f / sqrtf(p * (1.0f / D) + EPS);
#pragma unroll
            for (int i = 0; i < 8; ++i) { const int d = 4 * (lane + 64 * i);
                f32x4 v = xv[i]; const f32x4 c = cg[i] * rstd_y;
                v[0] += c[0] * bflo(yw[i].x); v[1] += c[1] * bfhi(yw[i].x); v[2] += c[2] * bflo(yw[i].y); v[3] += c[3] * bfhi(yw[i].y);
                __builtin_nontemporal_store(v, (f32x4*)(out + (size_t)r * D + d)); xv[i] = v; }
        }
        if (k < 3) {
#pragma unroll
            for (int i = 0; i < 8; ++i) { const f32x4 v = xv[i]; ss += (v[0] * v[0] + v[1] * v[1]) + (v[2] * v[2] + v[3] * v[3]); }
            ss = wave_sum(ss);
            const float rstd = 1.0f / sqrtf(ss * (1.0f / D) + EPS);
            const bool keep = (k == 1 || (EXACT_FFN0 && k == 0)) && ((r & (SEQ - 1)) == 0);
#pragma unroll
            for (int i = 0; i < 8; ++i) { const int d = 4 * (lane + 64 * i);
                const f32x4 hf = xv[i] * rstd * AVL[lane + 64 * i] + SHL[lane + 64 * i];
                u32x2 o; o.x = pk2(hf[0], hf[1]); o.y = pk2(hf[2], hf[3]);
                *(u32x2*)(H + (size_t)r * D + d) = o;
                if (keep) *(f32x4*)((k == 0 ? H0A : H0) + (size_t)b * D + d) = hf; }
        }
    }
#undef RP_LOAD
}

__device__ __forceinline__ void gate_unit(int pm, const bf16* __restrict__ H, const bf16* __restrict__ Wg, const float* __restrict__ b_i, const float* __restrict__ b_f, float* __restrict__ G, int w, int lane) {
    const int fr = lane & 15, fq = lane >> 4;
    const bf16* a0 = H + (size_t)(pm * 256 + 32 * w + fr) * D + 8 * fq;
    const bf16* a1 = a0 + (size_t)16 * D;
    const bf16* bp = Wg + (size_t)(fr & 7) * D + 8 * fq;
    f32x4 acc0 = (f32x4){0.f, 0.f, 0.f, 0.f}, acc1 = acc0;
#pragma unroll 8
    for (int ks = 0; ks < 64; ++ks) {
        const bf16x8 bv = *(const bf16x8*)(bp + 32 * ks), x0 = *(const bf16x8*)(a0 + 32 * ks), x1 = *(const bf16x8*)(a1 + 32 * ks);
        acc0 = MFMA16(bv, x0, acc0); acc1 = MFMA16(bv, x1, acc1);
    }
    if (fq < 2) {
        const f32x4 bias = fq == 0 ? *(const f32x4*)b_i : *(const f32x4*)b_f;
        *(f32x4*)(G + (size_t)(pm * 256 + 32 * w + fr) * 8 + 4 * fq) = acc0 + bias;
        *(f32x4*)(G + (size_t)(pm * 256 + 32 * w + 16 + fr) * 8 + 4 * fq) = acc1 + bias;
    }
}
__device__ __forceinline__ void s00_task(int b, int h, const float* __restrict__ H0, const float* __restrict__ w_in, const float* __restrict__ conv_w, const float* __restrict__ conv_b,
                                         float* __restrict__ S00, LAS unsigned char* lds, int tid, int wid, int lane) {
    LAS float* red = (LAS float*)lds;
    LAS float* qk = (LAS float*)(lds + 8192);
    const int col = (lane < 32) ? (128 * h + 4 * lane) : (512 + 128 * h + 4 * (lane - 32));
    const float* hp = H0 + (size_t)b * D + wid * 256;
    const float* wp = w_in + (size_t)(wid * 256) * NIN + col;
    f32x4 acc = (f32x4){0.f, 0.f, 0.f, 0.f};
#pragma unroll 32
    for (int k = 0; k < 256; ++k) { const float hv = hp[k]; const f32x4 wv = *(const f32x4*)(wp + (size_t)k * NIN); acc += wv * hv; }
    *(LAS f32x4*)(red + wid * 256 + 4 * lane) = acc;
    __syncthreads();
    if (tid < 256) {
        float p = 0.f;
#pragma unroll
        for (int w8 = 0; w8 < 8; ++w8) p += red[w8 * 256 + tid];
        const int ch = (tid < 128) ? (128 * h + tid) : (512 + 128 * h + (tid - 128));
        float y = conv_w[3 * 1024 + ch] * p + conv_b[ch];
        y = y / (1.0f + expf(-y));
        if (tid >= 128) y *= 0.08838834764831845f;
        qk[tid] = y;
    }
    __syncthreads();
    if (wid == 0) { float v = qk[lane] * qk[128 + lane] + qk[64 + lane] * qk[192 + lane]; v = wave_sum(v); if (lane == 0) S00[b * 4 + h] = v; }
    __syncthreads();
}

constexpr int ML_QS = 0, ML_KS = 34816, ML_KT = 69632, ML_VT = 104448, ML_CB = 126208, ML_GA = 147968, ML_GB = ML_GA + 512, ML_IS = ML_GB + 512, ML_EMT = ML_IS + 512,
              ML_WL = ML_EMT + 512, ML_TMP = ML_WL + 512, ML_SC = ML_TMP + 512;
static_assert(ML_SC + 64 <= LDS_BYTES, "LDS map");
__device__ __forceinline__ float scan_add(float v, int lane) {
#pragma unroll
    for (int o = 1; o < 64; o <<= 1) { const float t = __shfl_up(v, o); if (lane >= o) v += t; }
    return v;
}
__device__ __forceinline__ float scan_max(float v, int lane) {
#pragma unroll
    for (int o = 1; o < 64; o <<= 1) { const float t = __shfl_up(v, o); if (lane >= o) v = fmaxf(v, t); }
    return v;
}
__device__ __forceinline__ float logsig(float v) { return fminf(v, 0.f) - log1pf(expf(-fabsf(v))); }
__device__ __forceinline__ void mlstm_item(int b, int h, int sl, const bf16* __restrict__ PROJ, const float* __restrict__ G, const float* __restrict__ conv_w, const float* __restrict__ conv_b,
                                           bf16* __restrict__ MIX, float* __restrict__ HSSQ, const float* __restrict__ S00, LAS unsigned char* lds, int tid, int w, int lane) {
    const int fr = lane & 15, fq = lane >> 4;
    LAS bf16* QS = (LAS bf16*)(lds + ML_QS); LAS bf16* KS = (LAS bf16*)(lds + ML_KS); LAS bf16* KT = (LAS bf16*)(lds + ML_KT);
    LAS bf16* VT = (LAS bf16*)(lds + ML_VT); LAS bf16* CB = (LAS bf16*)(lds + ML_CB);
    LAS float* GA = (LAS float*)(lds + ML_GA); LAS float* GB = (LAS float*)(lds + ML_GB); LAS float* IS = (LAS float*)(lds + ML_IS);
    LAS float* EMT = (LAS float*)(lds + ML_EMT); LAS float* WL = (LAS float*)(lds + ML_WL); LAS float* SC = (LAS float*)(lds + ML_SC);
    f32x4 st[5];
#pragma unroll
    for (int e = 0; e < 5; ++e) st[e] = (f32x4){0.f, 0.f, 0.f, 0.f};
    float m_prev = 0.f;
    for (int i = tid; i < 80 * LDP / 2; i += 512) ((LAS unsigned*)CB)[i] = 0u;
    for (int i = tid; i < 16 * LDP; i += 512) VT[64 * LDP + i] = (i < LDP) ? (bf16)0x3F80 : (bf16)0;
    __syncthreads();
    const int cgi = tid & 31, isk = cgi >> 4, cg8 = cgi & 15, t0 = 8 * (tid >> 5);
    const int colp = isk * 512 + h * 128 + 8 * cg8;
    u32x4 raw[11]; u32x4 vraw[2]; float gpre[4] = {0.f, 0.f, 0.f, 0.f};
#define ML_LOAD(c_) do { const int rl_ = b * SEQ + (c_) * 128; \
        _Pragma("unroll") for (int i = 0; i < 11; ++i) { const int tt = t0 - 3 + i; \
            raw[i] = ((c_) > 0 || tt >= 0) ? *(const u32x4*)(PROJ + (size_t)(rl_ + tt) * NPROJ + colp) : (u32x4){0u, 0u, 0u, 0u}; } \
        _Pragma("unroll") for (int i = 0; i < 2; ++i) { const int idx = tid + 512 * i; \
            vraw[i] = *(const u32x4*)(PROJ + (size_t)(rl_ + (idx >> 3)) * NPROJ + 1024 + h * 256 + sl * 64 + 8 * (idx & 7)); } \
        if (w == 0) { gpre[0] = G[(size_t)(rl_ + lane) * 8 + h]; gpre[1] = G[(size_t)(rl_ + lane) * 8 + 4 + h]; \
                      gpre[2] = G[(size_t)(rl_ + 64 + lane) * 8 + h]; gpre[3] = G[(size_t)(rl_ + 64 + lane) * 8 + 4 + h]; } } while (0)
    ML_LOAD(0);
    for (int c = 0; c < 16; ++c) {
        const int r0 = b * SEQ + c * 128;
        if (w == 0) {
            const float ig1 = gpre[0], fg1 = gpre[1], ig2 = gpre[2], fg2 = gpre[3];
            const float bc1 = scan_add(logsig(fg1), lane); const float tot1 = __shfl(bc1, 63);
            const float bc2 = scan_add(logsig(fg2), lane) + tot1;
            const float ga1 = ig1 - bc1, ga2 = ig2 - bc2;
            const float pm1 = scan_max(ga1, lane); const float pmt = __shfl(pm1, 63);
            const float pm2 = fmaxf(scan_max(ga2, lane), pmt);
            const float b_last = __shfl(bc2, 63), amax = __shfl(pm2, 63);
            const float m_loc = b_last + amax, m_new = fmaxf(b_last + m_prev, m_loc), s_fac = expf(m_loc - m_new);
            { const float m_inter = bc1 + m_prev, m_t = fmaxf(m_inter, bc1 + pm1);
              IS[lane] = expf(m_inter - m_t); GB[lane] = bc1 - m_t; EMT[lane] = expf(-m_t); GA[lane] = ga1; WL[lane] = s_fac * expf(ga1 - amax); }
            { const float m_inter = bc2 + m_prev, m_t = fmaxf(m_inter, bc2 + pm2);
              IS[64 + lane] = expf(m_inter - m_t); GB[64 + lane] = bc2 - m_t; EMT[64 + lane] = expf(-m_t); GA[64 + lane] = ga2; WL[64 + lane] = s_fac * expf(ga2 - amax); }
            if (lane == 63) { SC[0] = b_last; SC[1] = amax; }
        }
#pragma unroll
        for (int i = 0; i < 2; ++i) {
            const int idx = tid + 512 * i, s = idx >> 3, eg = idx & 7; const u32x4 rv = vraw[i];
            LAS bf16* vp = VT + (8 * eg) * LDP + s;
            vp[0 * LDP] = (bf16)(rv.x & 0xffffu); vp[1 * LDP] = (bf16)(rv.x >> 16); vp[2 * LDP] = (bf16)(rv.y & 0xffffu); vp[3 * LDP] = (bf16)(rv.y >> 16);
            vp[4 * LDP] = (bf16)(rv.z & 0xffffu); vp[5 * LDP] = (bf16)(rv.z >> 16); vp[6 * LDP] = (bf16)(rv.w & 0xffffu); vp[7 * LDP] = (bf16)(rv.w >> 16);
        }
        __syncthreads();
        const float b_last = SC[0], amax = SC[1];
        const float m_loc = b_last + amax, m_new = fmaxf(b_last + m_prev, m_loc);
        const float a_fac = expf(b_last + m_prev - m_new);
        {
            f32x4 wl0 = (f32x4){0.f, 0.f, 0.f, 0.f}, wl1 = wl0;
            if (isk) { wl0 = *(const LAS f32x4*)(WL + t0); wl1 = *(const LAS f32x4*)(WL + t0 + 4); }
            const float scl = isk ? 0.08838834764831845f : 1.0f;
            LAS bf16* dst = (isk ? KS : QS) + t0 * LDP + 8 * cg8;
            int colw = colp; asm volatile("" : "+v"(colw));
#pragma unroll
            for (int ep = 0; ep < 4; ++ep) {
                float xl[11], xh[11];
#pragma unroll
                for (int i = 0; i < 11; ++i) { const unsigned wd = raw[i][ep]; xl[i] = bflo(wd); xh[i] = bfhi(wd); }
                f32x2 wj[4];
#pragma unroll
                for (int j = 0; j < 4; ++j) wj[j] = *(const f32x2*)(conv_w + j * 1024 + colw + 2 * ep);
                const f32x2 bb = *(const f32x2*)(conv_b + colw + 2 * ep);
                float yl[8], yh[8];
#pragma unroll
                for (int o = 0; o < 8; ++o) {
                    float a0 = bb.x, a1 = bb.y;
#pragma unroll
                    for (int j = 0; j < 4; ++j) { a0 += wj[j].x * xl[o + j]; a1 += wj[j].y * xh[o + j]; }
                    yl[o] = pg8::silu_f(a0) * scl; yh[o] = pg8::silu_f(a1) * scl;
                    *(LAS unsigned*)(dst + o * LDP + 2 * ep) = pk2(yl[o], yh[o]);
                }
                if (isk) {
                    u32x4 k0, k1;
                    k0.x = pk2(yl[0] * wl0[0], yl[1] * wl0[1]); k0.y = pk2(yl[2] * wl0[2], yl[3] * wl0[3]); k0.z = pk2(yl[4] * wl1[0], yl[5] * wl1[1]); k0.w = pk2(yl[6] * wl1[2], yl[7] * wl1[3]);
                    k1.x = pk2(yh[0] * wl0[0], yh[1] * wl0[1]); k1.y = pk2(yh[2] * wl0[2], yh[3] * wl0[3]); k1.z = pk2(yh[4] * wl1[0], yh[5] * wl1[1]); k1.w = pk2(yh[6] * wl1[2], yh[7] * wl1[3]);
                    *(LAS u32x4*)(KT + (8 * cg8 + 2 * ep) * LDP + t0) = k0;
                    *(LAS u32x4*)(KT + (8 * cg8 + 2 * ep + 1) * LDP + t0) = k1;
                }
            }
        }
        if (c + 1 < 16) ML_LOAD(c + 1);
        __syncthreads();
        f32x4 S[8];
#pragma unroll
        for (int s8 = 0; s8 < 8; ++s8) S[s8] = (f32x4){0.f, 0.f, 0.f, 0.f};
#pragma unroll 1
        for (int ks = 0; ks < 4; ++ks) {
            const bf16x8 a = frag(lds + ML_QS, 16 * w + fr, 32 * ks + 8 * fq);
#pragma unroll
            for (int s8 = 0; s8 < 8; ++s8) if (s8 <= w) { const bf16x8 bk = frag(lds + ML_KS, 16 * s8 + fr, 32 * ks + 8 * fq); S[s8] = MFMA16(bk, a, S[s8]); }
        }
        if (c == 0 && tid == 0) S[0][0] = S00[b * 4 + h];
        __syncthreads();
        {
            const int t = 16 * w + fr; const float gb = GB[t];
#pragma unroll
            for (int s8 = 0; s8 < 8; ++s8) {
                const f32x4 ga4 = *(const LAS f32x4*)(GA + 16 * s8 + 4 * fq);
                float pv[4];
#pragma unroll
                for (int j = 0; j < 4; ++j) { const int s = 16 * s8 + 4 * fq + j; pv[j] = (s8 <= w && s <= t) ? S[s8][j] * __expf(gb + ga4[j]) : 0.f; }
                u32x2 o; o.x = pk2(pv[0], pv[1]); o.y = pk2(pv[2], pv[3]);
                *(LAS u32x2*)(KS + t * LDP + 16 * s8 + 4 * fq) = o;
            }
        }
        __syncthreads();
        {
            f32x4 a1[5], a2[5];
#pragma unroll
            for (int e = 0; e < 5; ++e) { a1[e] = (f32x4){0.f, 0.f, 0.f, 0.f}; a2[e] = (f32x4){0.f, 0.f, 0.f, 0.f}; }
#pragma unroll 1
            for (int ks = 0; ks < 4; ++ks) {
                const bf16x8 ap = frag(lds + ML_KS, 16 * w + fr, 32 * ks + 8 * fq), aq = frag(lds + ML_QS, 16 * w + fr, 32 * ks + 8 * fq);
#pragma unroll
                for (int e = 0; e < 5; ++e) {
                    const bf16x8 bv = frag(lds + ML_VT, 16 * e + fr, 32 * ks + 8 * fq), bcb = frag(lds + ML_CB, 16 * e + fr, 32 * ks + 8 * fq);
                    a1[e] = MFMA16(bv, ap, a1[e]); a2[e] = MFMA16(bcb, aq, a2[e]);
                }
            }
            const int t = 16 * w + fr; const float isv = IS[t], emt = EMT[t];
            const float den0 = isv * a2[4][0] + a1[4][0];
            const float den = __shfl(den0, fr);
            const float inv = 1.0f / fmaxf(fabsf(den), emt);
            float ssq = 0.f;
            bf16* op = MIX + (size_t)(r0 + t) * D + h * 256 + sl * 64 + 4 * fq;
#pragma unroll
            for (int e = 0; e < 4; ++e) {
                const float h0 = (isv * a2[e][0] + a1[e][0]) * inv, h1 = (isv * a2[e][1] + a1[e][1]) * inv, h2 = (isv * a2[e][2] + a1[e][2]) * inv, h3 = (isv * a2[e][3] + a1[e][3]) * inv;
                ssq += (h0 * h0 + h1 * h1) + (h2 * h2 + h3 * h3);
                u32x2 o; o.x = pk2(h0, h1); o.y = pk2(h2, h3);
                *(u32x2*)(op + 16 * e) = o;
            }
            ssq += __shfl_xor(ssq, 16); ssq += __shfl_xor(ssq, 32);
            if (fq == 0) HSSQ[(size_t)(r0 + t) * 16 + 4 * h + sl] = ssq;
        }
        __syncthreads();
#pragma unroll
        for (int e = 0; e < 5; ++e) st[e] = st[e] * a_fac;
#pragma unroll
        for (int ks = 0; ks < 4; ++ks) {
            const bf16x8 bk = frag(lds + ML_KT, 16 * w + fr, 32 * ks + 8 * fq);
#pragma unroll
            for (int e = 0; e < 5; ++e) { const bf16x8 av = frag(lds + ML_VT, 16 * e + fr, 32 * ks + 8 * fq); st[e] = MFMA16(bk, av, st[e]); }
        }
#pragma unroll
        for (int e = 0; e < 5; ++e) { u32x2 o; o.x = pk2(st[e][0], st[e][1]); o.y = pk2(st[e][2], st[e][3]);
            *(LAS u32x2*)(CB + (16 * e + fr) * LDP + 16 * w + 4 * fq) = o; }
        m_prev = m_new;
        __syncthreads();
    }
}

constexpr int SG_WS = 0, SG_VP = 34816, SG_MU = 69632, SG_RS = SG_MU + 512;
__device__ __forceinline__ bool sg_item_of(int q, int blk, int nblk, int& g, int& r0) {
    int pair;
    if ((nblk % 8) == 0) { g = blk & 7; pair = (blk >> 3) + (nblk >> 3) * q; if (pair >= 256) return false; }
    else { const int it = blk + nblk * q; if (it >= 8 * 256) return false; g = it & 7; pair = it >> 3; }
    r0 = (pair >> 4) * SEQ + (pair & 15) * 128; return true;
}
__device__ __forceinline__ void sg_items(int blk, int nblk, const bf16* __restrict__ PROJ, const float* __restrict__ gvstat, const float* __restrict__ ln_g, const float* __restrict__ ln_b,
                                         const float* __restrict__ w_sp, const float* __restrict__ b_sp, bf16* __restrict__ MIX, LAS unsigned char* lds, int tid, int w, int lane) {
    const int fr = lane & 15, fq = lane >> 4;
    LAS bf16* WS = (LAS bf16*)(lds + SG_WS); LAS bf16* VP = (LAS bf16*)(lds + SG_VP); LAS float* MU = (LAS float*)(lds + SG_MU); LAS float* RS = (LAS float*)(lds + SG_RS);
    int cur_g = -1, g, r0;
    if (!sg_item_of(0, blk, nblk, g, r0)) return;
    f32x4 stn[2]; u32x4 rawn[4]; u32x2 uwn[8];
#define SG_LOAD(g_, r0_) do { \
        const f32x4* gp_ = (const f32x4*)(gvstat + (size_t)((r0_) + (tid >> 2)) * 32) + 2 * (tid & 3); stn[0] = gp_[0]; stn[1] = gp_[1]; \
        _Pragma("unroll") for (int i = 0; i < 4; ++i) { const int idx = tid + 512 * i; rawn[i] = *(const u32x4*)(PROJ + (size_t)((r0_) + (idx >> 4)) * NPROJ + 4096 + 128 * (g_) + 8 * (idx & 15)); } \
        const bf16* up_ = PROJ + (size_t)((r0_) + 16 * w + fr) * NPROJ + 3072 + 128 * (g_) + 4 * fq; \
        _Pragma("unroll") for (int ct = 0; ct < 8; ++ct) uwn[ct] = *(const u32x2*)(up_ + 16 * ct); } while (0)
    SG_LOAD(g, r0);
    for (int q = 0;; ++q) {
        if (g != cur_g) {
            __syncthreads();
            for (int idx = tid; idx < 128 * 32; idx += 512) { const int t = idx >> 5, s0 = 4 * (idx & 31);
                f32x4 v = *(const f32x4*)(w_sp + (size_t)(g * 128 + t) * 128 + s0);
                u32x2 o; o.x = pk2(s0 <= t ? v[0] : 0.f, s0 + 1 <= t ? v[1] : 0.f); o.y = pk2(s0 + 2 <= t ? v[2] : 0.f, s0 + 3 <= t ? v[3] : 0.f);
                *(LAS u32x2*)(WS + t * LDP + s0) = o; }
            cur_g = g;
        }
        {
            float s1 = (stn[0][0] + stn[0][2]) + (stn[1][0] + stn[1][2]), s2 = (stn[0][1] + stn[0][3]) + (stn[1][1] + stn[1][3]);
            s1 += __shfl_xor(s1, 1); s2 += __shfl_xor(s2, 1); s1 += __shfl_xor(s1, 2); s2 += __shfl_xor(s2, 2);
            const float mean = s1 * (1.0f / 1024.0f), var = fmaxf(s2 * (1.0f / 1024.0f) - mean * mean, 0.f);
            if ((tid & 3) == 0) { MU[tid >> 2] = mean; RS[tid >> 2] = 1.0f / sqrtf(var + EPS); }
        }
        u32x2 uw[8];
#pragma unroll
        for (int ct = 0; ct < 8; ++ct) uw[ct] = uwn[ct];
        __syncthreads();
#pragma unroll
        for (int i = 0; i < 4; ++i) {
            const int idx = tid + 512 * i, s = idx >> 4, cg8 = idx & 15, ch = 128 * g + 8 * cg8;
            const u32x4 raw = rawn[i];
            const f32x4 g0 = *(const f32x4*)(ln_g + ch), g1 = *(const f32x4*)(ln_g + ch + 4), c0 = *(const f32x4*)(ln_b + ch), c1 = *(const f32x4*)(ln_b + ch + 4);
            const float mu = MU[s], rs = RS[s];
            LAS bf16* vp = VP + (8 * cg8) * LDP + s;
            vp[0 * LDP] = f2bf((bflo(raw.x) - mu) * rs * g0[0] + c0[0]); vp[1 * LDP] = f2bf((bfhi(raw.x) - mu) * rs * g0[1] + c0[1]);
            vp[2 * LDP] = f2bf((bflo(raw.y) - mu) * rs * g0[2] + c0[2]); vp[3 * LDP] = f2bf((bfhi(raw.y) - mu) * rs * g0[3] + c0[3]);
            vp[4 * LDP] = f2bf((bflo(raw.z) - mu) * rs * g1[0] + c1[0]); vp[5 * LDP] = f2bf((bfhi(raw.z) - mu) * rs * g1[1] + c1[1]);
            vp[6 * LDP] = f2bf((bflo(raw.w) - mu) * rs * g1[2] + c1[2]); vp[7 * LDP] = f2bf((bfhi(raw.w) - mu) * rs * g1[3] + c1[3]);
        }
        const int gc = g, rc = r0;
        const bool more = sg_item_of(q + 1, blk, nblk, g, r0);
        if (more) SG_LOAD(g, r0);
        __syncthreads();
        f32x4 z[8];
#pragma unroll
        for (int ct = 0; ct < 8; ++ct) z[ct] = (f32x4){0.f, 0.f, 0.f, 0.f};
#pragma unroll
        for (int ks = 0; ks < 4; ++ks) {
            const bf16x8 a = frag(lds + SG_WS, 16 * w + fr, 32 * ks + 8 * fq);
#pragma unroll
            for (int ct = 0; ct < 8; ++ct) { const bf16x8 bv = frag(lds + SG_VP, 16 * ct + fr, 32 * ks + 8 * fq); z[ct] = MFMA16(bv, a, z[ct]); }
        }
        const int t = 16 * w + fr; const float bs = b_sp[gc * 128 + t];
        bf16* op = MIX + (size_t)(rc + t) * D + 1024 + 128 * gc + 4 * fq;
#pragma unroll
        for (int ct = 0; ct < 8; ++ct) {
            u32x2 o; o.x = pk2(bflo(uw[ct].x) * (z[ct][0] + bs), bfhi(uw[ct].x) * (z[ct][1] + bs)); o.y = pk2(bflo(uw[ct].y) * (z[ct][2] + bs), bfhi(uw[ct].y) * (z[ct][3] + bs));
            *(u32x2*)(op + 16 * ct) = o;
        }
        if (!more) break;
        __syncthreads();
    }
#undef SG_LOAD
}
__device__ __forceinline__ void headnorm_pass(bf16* MIX, const bf16* __restrict__ PROJ, const float* __restrict__ HSSQ, const float* __restrict__ g_mh, int gw, int NGW, int lane) {
    f32x4 g0[2], g1[2];
#pragma unroll
    for (int i = 0; i < 2; ++i) { const int col = 8 * lane + 512 * i; g0[i] = *(const f32x4*)(g_mh + col); g1[i] = *(const f32x4*)(g_mh + col + 4); }
    for (int r0 = gw; r0 < T; r0 += 2 * NGW) {
        u32x4 hv[2][2], ov[2][2]; f32x4 q[2][2];
#pragma unroll
        for (int j = 0; j < 2; ++j) { const int r = r0 + j * NGW; if (r < T) {
#pragma unroll
            for (int i = 0; i < 2; ++i) { const int col = 8 * lane + 512 * i, hd = col >> 8;
                q[j][i] = *(const f32x4*)(HSSQ + (size_t)r * 16 + 4 * hd);
                hv[j][i] = *(const u32x4*)(MIX + (size_t)r * D + col);
                ov[j][i] = __builtin_nontemporal_load((const u32x4*)(PROJ + (size_t)r * NPROJ + 2048 + col)); } } }
#pragma unroll
        for (int j = 0; j < 2; ++j) { const int r = r0 + j * NGW; if (r < T) {
#pragma unroll
            for (int i = 0; i < 2; ++i) { const int col = 8 * lane + 512 * i;
                const float rstd = 1.0f / sqrtf(((q[j][i][0] + q[j][i][1]) + (q[j][i][2] + q[j][i][3])) * (1.0f / 256.0f) + EPS);
                const u32x4 h = hv[j][i], o4 = ov[j][i]; const f32x4 ga = g0[i] * rstd, gb = g1[i] * rstd;
                u32x4 o;
                o.x = pk2(bflo(h.x) * ga[0] * bflo(o4.x), bfhi(h.x) * ga[1] * bfhi(o4.x));
                o.y = pk2(bflo(h.y) * ga[2] * bflo(o4.y), bfhi(h.y) * ga[3] * bfhi(o4.y));
                o.z = pk2(bflo(h.z) * gb[0] * bflo(o4.z), bfhi(h.z) * gb[1] * bfhi(o4.z));
                o.w = pk2(bflo(h.w) * gb[2] * bflo(o4.w), bfhi(h.w) * gb[3] * bfhi(o4.w));
                *(u32x4*)(MIX + (size_t)r * D + col) = o; } } }
    }
}

#define XB_TMO      128
#define XB_XCNT(j)  (256  + 64 * (j))
#define XB_XSUB(j)  (1280 + 64 * (j))
#define XB_XGEN(j)  (2304 + 64 * (j))
#define XB_TOP      3328
#define XB_TOPGEN   3392
#define XCD_BAR_WORDS 3456
#define XB_SPIN_CAP (1u << 18)

__device__ __forceinline__ unsigned xb_ld(unsigned* p)              { return __hip_atomic_load(p, __ATOMIC_RELAXED, __HIP_MEMORY_SCOPE_AGENT); }
__device__ __forceinline__ unsigned xb_add(unsigned* p, unsigned v) { return __hip_atomic_fetch_add(p, v, __ATOMIC_RELAXED, __HIP_MEMORY_SCOPE_AGENT); }
__device__ __forceinline__ unsigned xb_xcc_id() { return (unsigned)__builtin_amdgcn_s_getreg((3 << 11) | 20) & 0xFu; }
#define XB_SPIN(cond, bar) do { unsigned _sp = 0; while (cond) { __builtin_amdgcn_s_sleep(1); \
    if ((++_sp & 255u) == 0u) { if (xb_ld(&(bar)[XB_TMO])) break; if (_sp > XB_SPIN_CAP) { atomicAdd(&(bar)[XB_TMO], 1u); break; } } } } while (0)

struct XcdBarrier {
    unsigned* bar; unsigned x;
    volatile LAS unsigned* st;
};

__device__ __forceinline__ XcdBarrier xcd_barrier_post(unsigned* bar, volatile LAS unsigned* st) {
    XcdBarrier b; b.bar = bar; b.x = xb_xcc_id(); b.st = st;
    if (threadIdx.x == 0) (void)xb_add(&bar[XB_XCNT(b.x)], 1u);
    return b;
}
__device__ __forceinline__ void xcd_barrier_complete(unsigned* bar, unsigned x, unsigned& nloc, unsigned& nx) {
    const unsigned G = gridDim.x * gridDim.y * gridDim.z;
    unsigned sum, cnt, mine, sp = 0u;
    for (;;) {
        sum = 0u; cnt = 0u; mine = 0u;
#pragma unroll
        for (unsigned j = 0; j < 16; ++j) { const unsigned c = xb_ld(&bar[XB_XCNT(j)]); sum += c; cnt += (c > 0u) ? 1u : 0u; mine = (j == x) ? c : mine; }
        if (sum == G) break;
        __builtin_amdgcn_s_sleep(1);
        if ((++sp & 255u) == 0u) { if (xb_ld(&bar[XB_TMO])) break; if (sp > XB_SPIN_CAP) { atomicAdd(&bar[XB_TMO], 1u); break; } }
    }
    nloc = mine > 0u ? mine : 1u; nx = cnt > 0u ? cnt : 1u;
}

__device__ __forceinline__ void xcd_barrier(const XcdBarrier& b) {
    asm volatile("s_waitcnt vmcnt(0)" ::: "memory");
    __syncthreads();
    if (threadIdx.x == 0) {
        unsigned* bar = b.bar;
        __builtin_amdgcn_s_waitcnt(0);
        unsigned nloc = b.st[0], nx = b.st[1];
        if (nloc == 0u) { xcd_barrier_complete(bar, b.x, nloc, nx); b.st[0] = nloc; b.st[1] = nx; }
        const unsigned old = xb_add(&bar[XB_XSUB(b.x)], 1u);
        const unsigned gen = old / nloc;
        if (old + 1u == (gen + 1u) * nloc) {
            __builtin_amdgcn_fence(__ATOMIC_RELEASE, "agent");
            asm volatile("s_waitcnt vmcnt(0)" ::: "memory");
            const unsigned og = xb_add(&bar[XB_TOP], 1u);
            const unsigned tg = og / nx;
            if (og + 1u == (tg + 1u) * nx) xb_add(&bar[XB_TOPGEN], 1u);
            else XB_SPIN(xb_ld(&bar[XB_TOPGEN]) == tg, bar);
            __builtin_amdgcn_fence(__ATOMIC_ACQUIRE, "agent");
            xb_add(&bar[XB_XGEN(b.x)], 1u);
            asm volatile("s_waitcnt vmcnt(0)" ::: "memory");
        } else {
            XB_SPIN(xb_ld(&bar[XB_XGEN(b.x)]) == gen, bar);
            __builtin_amdgcn_fence(__ATOMIC_ACQUIRE, "agent");
            asm volatile("s_waitcnt vmcnt(0)" ::: "memory");
        }
    }
    __syncthreads();
}

struct Args { const float* in[20]; float* out; unsigned char* ws; };
#ifndef GEMM_REPS
#define GEMM_REPS 1
#endif
#define REPLOOP _Pragma("unroll 1") for (int rep_ = 0; rep_ < GEMM_REPS; ++rep_)
__global__ void __launch_bounds__(512, 2) mega_fwd(Args a) {
    extern __shared__ __attribute__((aligned(16))) unsigned char lds_raw[];
    cg::grid_group grid = cg::this_grid();
    LAS unsigned char* lds = (LAS unsigned char*)lds_raw;
    const int blk = blockIdx.x, G_ = gridDim.x, NGW = G_ * 8;
#define FRESH() int tid = threadIdx.x; asm volatile("" : "+v"(tid)); const int lane = tid & 63, wid = __builtin_amdgcn_readfirstlane(tid >> 6), gw = blk * 8 + wid; (void)lane; (void)gw;
    unsigned char* ws = a.ws;
    float* MOD = (float*)(ws + OFF_MOD); float* YSSQ = (float*)(ws + OFF_YSSQ); float* GVSTAT = (float*)(ws + OFF_GVSTAT); float* HSSQ = (float*)(ws + OFF_HSSQ); float* GT = (float*)(ws + OFF_G);
    float* H0 = (float*)(ws + OFF_H0); float* S00 = (float*)(ws + OFF_S00); float* H0A = (float*)(ws + OFF_H0A);
    float* GX = (float*)(ws + OFF_GX); float* UX = (float*)(ws + OFF_UX); float* YP = (float*)(ws + OFF_YP);
    bf16* Hb = (bf16*)(ws + OFF_H); bf16* Yb = (bf16*)(ws + OFF_Y); bf16* ACT = (bf16*)(ws + OFF_ACT);
    const float* x = a.in[0];
    unsigned* BARW = (unsigned*)ws;
    volatile LAS unsigned* BST = (volatile LAS unsigned*)(lds + LDS_BYTES - 64);
    if (threadIdx.x < 2) BST[threadIdx.x] = 0u;
    if (blk == 0) { for (int i = threadIdx.x; i < XCD_BAR_WORDS; i += 512) __hip_atomic_store(BARW + i, 0u, __ATOMIC_RELAXED, __HIP_MEMORY_SCOPE_AGENT); }

#ifndef NO_P0
    { FRESH();
    if (blk < 144) gemv16_item<0, 2, 8>(a.in[1], nullptr, D, a.in[2], NMOD, 128 * blk, 0, 32, a.in[3], MOD, NMOD, lds, tid, wid, lane);
    else if (G_ < 144) { for (int it = blk; it < 144; it += G_) gemv16_item<0, 2, 8>(a.in[1], nullptr, D, a.in[2], NMOD, 128 * it, 0, 32, a.in[3], MOD, NMOD, lds, tid, wid, lane); }
    p0_transposes(a.in, ws, lds, blk, G_, wid, lane); }
#endif
    grid.sync();
    XcdBarrier xbar = xcd_barrier_post(BARW, BST);
#define GSYNC() xcd_barrier(xbar)
#pragma unroll 1
    for (int k = 0; k < 3; ++k) {
#ifndef NO_ROW
        { FRESH(); row_pass(k, x, a.out, Yb, YSSQ, MOD, a.in[4], a.in[5], Hb, H0, H0A, YP, lds, wid, gw, NGW, lane); }
#endif
        GSYNC();
        if (k != 1) {
            const int f = k >> 1;
#ifndef NO_G1
            { pg8::Gemm g{Hb, (const bf16*)(ws + (f ? OFF_WGU1 : OFF_WGU0)), T, NGU, D}; pg8::StaticOrder S; S.init(T, NGU, G_, blk);
              pg8::EpiSwiglu E{ACT, DFF};
              REPLOOP pg8::gemm_phase<pg8::EpiSwiglu, pg8::StaticOrder, true, true>(lds, g, S, E); }
#endif
            if (EXACT_FFN0 && f == 0) { FRESH(); for (int it = blk; it < 176; it += G_) { const int up = it >= 88, nb = up ? it - 88 : it;
                gemv16_item<1, 1, 64>(H0A, nullptr, D, (up ? a.in[7] : a.in[6]), DFF, 64 * nb, 0, 32, nullptr, up ? UX : GX, DFF, lds, tid, wid, lane); } }
            GSYNC();
#ifndef NO_G2
            { pg8::Gemm g{ACT, (const bf16*)(ws + (f ? OFF_WD1 : OFF_WD0)), T, D, DFF}; pg8::StaticOrder S; S.init(T, D, G_, blk);
              pg8::EpiYStat E{Yb, D, YSSQ};
              REPLOOP pg8::gemm_phase<pg8::EpiYStat, pg8::StaticOrder, true, true>(lds, g, S, E); }
#endif
            if (EXACT_FFN0 && f == 0) { FRESH(); for (int it = G_ - 1 - blk; it < 128; it += G_) { const int q8 = it >> 4, nb = it & 15;
                gemv16_item<2, 2, 32>(GX, UX, DFF, a.in[8], D, 128 * nb, 11 * q8, 11 * q8 + 11, nullptr, YP + (size_t)q8 * 16 * D, D, lds, tid, wid, lane); } }
            GSYNC();
        } else {
            { FRESH(); for (int u = blk; u < T / 256; u += G_) gate_unit(u, Hb, (const bf16*)(ws + OFF_WIN) + (size_t)NPROJ * D, a.in[12], a.in[13], GT, wid, lane); }
            { FRESH(); for (int task = G_ - 1 - blk; task < 64; task += G_) s00_task(task >> 2, task & 3, H0, a.in[9], a.in[10], a.in[11], S00, lds, tid, wid, lane); }
#ifndef NO_G3
            { pg8::Gemm g{Hb, (const bf16*)(ws + OFF_WIN), T, NPROJ, D}; pg8::StaticOrder S; S.init(T, NPROJ, G_, blk);
              pg8::EpiProj E{ACT, NPROJ, GVSTAT, GT, a.in[12], a.in[13]};
              REPLOOP pg8::gemm_phase<pg8::EpiProj, pg8::StaticOrder, true, true>(lds, g, S, E); }
#endif
            GSYNC();
#ifndef NO_ML
#ifndef MIX_REPS
#define MIX_REPS 1
#endif
            _Pragma("unroll 1") for (int mrep = 0; mrep < MIX_REPS; ++mrep) {
            { FRESH(); for (int it = blk; it < 256; it += G_) mlstm_item(it >> 4, (it >> 2) & 3, it & 3, ACT, GT, a.in[10], a.in[11], Hb, HSSQ, S00, lds, tid, wid, lane); }
#endif
#ifndef NO_SG
            { FRESH(); sg_items(blk, G_, ACT, GVSTAT, a.in[15], a.in[16], a.in[17], a.in[18], Hb, lds, tid, wid, lane); }
#endif
            }
            GSYNC();
#ifndef NO_HN
            { FRESH(); headnorm_pass(Hb, ACT, HSSQ, a.in[14], gw, NGW, lane); }
#endif
            GSYNC();
#ifndef NO_G4
            { pg8::Gemm g{Hb, (const bf16*)(ws + OFF_WOUT), T, D, D}; pg8::StaticOrder S; S.init(T, D, G_, blk);
              pg8::EpiYStat E{Yb, D, YSSQ};
              REPLOOP pg8::gemm_phase<pg8::EpiYStat, pg8::StaticOrder, true, true>(lds, g, S, E); }
#endif
            GSYNC();
        }
    }
    { FRESH(); row_pass(3, x, a.out, Yb, YSSQ, MOD, a.in[4], a.in[5], Hb, H0, H0A, YP, lds, wid, gw, NGW, lane); }
}

extern "C" void kernel_launch(void* const* d_in, const int* in_sizes, int n_in, void* d_out, int out_size, void* d_ws, size_t ws_size, hipStream_t stream) {
    static int grid = 0;
    if (grid == 0) {
        if (n_in != 20 || out_size != T * D || ws_size < WS_END) { fprintf(stderr, "kernel_launch: unexpected shapes (n_in %d out %d ws %zu)\n", n_in, out_size, ws_size); grid = -1; return; }
        int dev = 0, cus = 0, per_cu = 0;
        hipGetDevice(&dev); hipDeviceGetAttribute(&cus, hipDeviceAttributeMultiprocessorCount, dev);
        if (hipFuncSetAttribute((const void*)mega_fwd, hipFuncAttributeMaxDynamicSharedMemorySize, LDS_BYTES) != hipSuccess) { fprintf(stderr, "kernel_launch: hipFuncSetAttribute failed\n"); grid = -1; return; }
        if (hipOccupancyMaxActiveBlocksPerMultiprocessor(&per_cu, (const void*)mega_fwd, 512, LDS_BYTES) != hipSuccess || per_cu < 1) { fprintf(stderr, "kernel_launch: occupancy query says %d\n", per_cu); per_cu = 1; }
        (void)hipGetLastError();
        grid = cus * per_cu;
        if (grid < 144) { fprintf(stderr, "kernel_launch: grid %d < 144 workgroups is not supported\n", grid); grid = -1; return; }
        fprintf(stderr, "kernel_launch: grid %d (cus %d x %d)\n", grid, cus, per_cu);
    }
    if (grid < 0) return;
    Args a{};
    for (int i = 0; i < 20; ++i) a.in[i] = (const float*)d_in[i];
    a.out = (float*)d_out; a.ws = (unsigned char*)d_ws;
    void* args[] = {&a};
    hipError_t e = hipLaunchCooperativeKernel((const void*)mega_fwd, dim3(grid), dim3(512), args, LDS_BYTES, stream);
    if (e != hipSuccess) fprintf(stderr, "cooperative launch failed: %s (grid %d)\n", hipGetErrorString(e), grid);
}
```

```cpp
#include <hip/hip_runtime.h>
#include <hip/hip_cooperative_groups.h>
#include <cstdio>
#include <cstdint>
namespace cg = cooperative_groups;
namespace pg8 {
#define PG8_LAS __attribute__((address_space(3)))
typedef unsigned short bf16_t;
typedef short bf16x8 __attribute__((ext_vector_type(8)));
typedef float f32x4 __attribute__((ext_vector_type(4)));
typedef unsigned u32x4 __attribute__((ext_vector_type(4)));
constexpr int BM = 256, BK = 64, HALF = 128, HTB = HALF * BK * 2  , STAGE_BYTES = 8 * HTB, NXCD = 8, WGM = 8;

__host__ __device__ __forceinline__ int lds_byte(int r, int c) { const int st = (r >> 4) * 2 + (c >> 5), rr = r & 15, cc = c & 31, ob = rr * 64 + cc * 2; return st * 1024 + (ob ^ (((ob >> 9) & 1) << 5)); }
__host__ __device__ __forceinline__ void stage_rc(int b, int& R, int& C) { const int st = b / 1024, sb = b % 1024, swz = sb ^ (((sb >> 9) & 1) << 5); R = (st >> 1) * 16 + swz / 64; C = (st & 1) * 32 + (swz % 64) / 2; }
__host__ __device__ __forceinline__ int perm32(int rho) { const int n = rho >> 4, i = rho & 15; return 8 * (i >> 2) + 4 * n + (i & 3); }

struct Unit { int pm, pn; };
struct Gemm { const bf16_t* A; const bf16_t* Bt; int M, N, K; };

struct StaticOrder {
    int nM, nN, nwg, G, c;
    __host__ __device__ void init(int M, int N, int G_, int c_) { nM = M / BM; nN = N / BM; nwg = nM * nN; G = G_; c = c_; }
    __host__ __device__ bool next(int i, Unit& u) const {
        const long L = (long)i * G + c; if (L >= nwg) return false;
        int wgid = (int)L; { const int q = nwg / NXCD, r = nwg % NXCD, xcd = wgid % NXCD, off = wgid / NXCD; wgid = (xcd < r ? xcd * (q + 1) : r * (q + 1) + (xcd - r) * q) + off; }
        const int nig = WGM * nN, gid = wgid / nig, fm = gid * WGM, gsz = (nM - fm) < WGM ? (nM - fm) : WGM;
        u.pm = fm + ((wgid % nig) % gsz); u.pn = (wgid % nig) / gsz; return true;
    }
    __device__ __forceinline__ void a_ready(const Unit&) const {}
    __device__ __forceinline__ void done(const Unit&) const {}
};
__device__ __forceinline__ unsigned cvt_pk_bf16(float lo, float hi) { unsigned r; asm volatile("v_cvt_pk_bf16_f32 %0, %1, %2" : "=v"(r) : "v"(lo), "v"(hi)); return r; }
typedef unsigned u32x2 __attribute__((ext_vector_type(2)));
__device__ __forceinline__ float fast_sigmoid(float v) { return __builtin_amdgcn_rcpf(1.0f + __builtin_amdgcn_exp2f(-1.44269504f * v)); }
__device__ __forceinline__ float silu_f(float v) { return v * fast_sigmoid(v); }
__device__ __forceinline__ float gelu_tanh_f(float v) { const float u = 1.59576912f * (v + 0.044715f * v * v * v); return v * fast_sigmoid(u); }

struct EpiSwiglu {
    static constexpr bool PERM = true, AFTER_DRAIN = false; static constexpr int NST = 8;
    bf16_t* O; int ldc;
    __device__ __forceinline__ void operator()(const f32x4 (&acc)[2][2][4][2], const Unit& u, int wr, int wc, int fr, int fq) const {
        const int row0 = u.pm * BM + wr * 64 + fr, col0 = u.pn * HALF + wc * 32 + 8 * fq;
#pragma unroll
        for (int ai = 0; ai < 2; ++ai)
#pragma unroll
            for (int m = 0; m < 4; ++m) {
                bf16_t* rowp = O + (size_t)(row0 + ai * HALF + m * 16) * ldc + col0;
                const f32x4 g0 = acc[ai][0][m][0], g1 = acc[ai][0][m][1], u0 = acc[ai][1][m][0], u1 = acc[ai][1][m][1];
                u32x4 w;
                w.x = cvt_pk_bf16(silu_f(g0[0]) * u0[0], silu_f(g0[1]) * u0[1]); w.y = cvt_pk_bf16(silu_f(g0[2]) * u0[2], silu_f(g0[3]) * u0[3]);
                w.z = cvt_pk_bf16(silu_f(g1[0]) * u1[0], silu_f(g1[1]) * u1[1]); w.w = cvt_pk_bf16(silu_f(g1[2]) * u1[2], silu_f(g1[3]) * u1[3]);
                *(u32x4*)rowp = w;
            }
    }
};
struct EpiYStat {
    static constexpr bool PERM = true, AFTER_DRAIN = false; static constexpr int NST = 24;
    bf16_t* Y; int ldc; float* ssq;
    __device__ __forceinline__ void operator()(const f32x4 (&acc)[2][2][4][2], const Unit& u, int wr, int wc, int fr, int fq) const {
        const int row0 = u.pm * BM + wr * 64 + fr, col0 = u.pn * BM + wc * 32 + 8 * fq;
#pragma unroll
        for (int ai = 0; ai < 2; ++ai)
#pragma unroll
            for (int m = 0; m < 4; ++m) {
                const int row = row0 + ai * HALF + m * 16;
                bf16_t* rowp = Y + (size_t)row * ldc + col0;
                float s = 0.f;
#pragma unroll
                for (int bj = 0; bj < 2; ++bj) {
                    const f32x4 v0 = acc[ai][bj][m][0], v1 = acc[ai][bj][m][1];
                    s += (v0[0] * v0[0] + v0[1] * v0[1]) + (v0[2] * v0[2] + v0[3] * v0[3]) + (v1[0] * v1[0] + v1[1] * v1[1]) + (v1[2] * v1[2] + v1[3] * v1[3]);
                    u32x4 w; w.x = cvt_pk_bf16(v0[0], v0[1]); w.y = cvt_pk_bf16(v0[2], v0[3]); w.z = cvt_pk_bf16(v1[0], v1[1]); w.w = cvt_pk_bf16(v1[2], v1[3]);
                    *(u32x4*)(rowp + bj * HALF) = w;
                }
                s += __shfl_xor(s, 16); s += __shfl_xor(s, 32);
                if (fq == 0) ssq[(size_t)row * 32 + u.pn * 4 + wc] = s;
            }
    }
};
struct EpiProj {
    static constexpr bool PERM = true, AFTER_DRAIN = false; static constexpr int NST = 16;
    bf16_t* P; int ldc; float* gvstat; float* G; const float* b_i; const float* b_f;
    __device__ __forceinline__ void operator()(const f32x4 (&acc)[2][2][4][2], const Unit& u, int wr, int wc, int fr, int fq) const {
        const int pn = u.pn;
        const int row0 = u.pm * BM + wr * 64 + fr;
        if (pn == 20) {
            if (wc == 0 && fq == 0) {
                const f32x4 bi = *(const f32x4*)b_i, bf = *(const f32x4*)b_f;
#pragma unroll
                for (int ai = 0; ai < 2; ++ai)
#pragma unroll
                    for (int m = 0; m < 4; ++m) {
                        const int row = row0 + ai * HALF + m * 16;
                        *(f32x4*)(G + (size_t)row * 8) = acc[ai][0][m][0] + bi;
                        *(f32x4*)(G + (size_t)row * 8 + 4) = acc[ai][0][m][1] + bf;
                    }
            }
            return;
        }
        const int mode = pn < 8 ? 0 : (pn < 12 ? 1 : (pn < 16 ? 2 : 3));
        const int col0 = pn * BM + wc * 32 + 8 * fq;
#pragma unroll
        for (int ai = 0; ai < 2; ++ai)
#pragma unroll
            for (int m = 0; m < 4; ++m) {
                const int row = row0 + ai * HALF + m * 16;
                bf16_t* rowp = P + (size_t)row * ldc + col0;
                float s1 = 0.f, s2 = 0.f;
#pragma unroll
                for (int bj = 0; bj < 2; ++bj) {
                    f32x4 v0 = acc[ai][bj][m][0], v1 = acc[ai][bj][m][1];
                    if (mode == 1) {
#pragma unroll
                        for (int j = 0; j < 4; ++j) { v0[j] = fast_sigmoid(v0[j]); v1[j] = fast_sigmoid(v1[j]); }
                    } else if (mode >= 2) {
#pragma unroll
                        for (int j = 0; j < 4; ++j) { v0[j] = gelu_tanh_f(v0[j]); v1[j] = gelu_tanh_f(v1[j]); }
                    }
                    s1 += (v0[0] + v0[1]) + (v0[2] + v0[3]) + (v1[0] + v1[1]) + (v1[2] + v1[3]);
                    s2 += (v0[0] * v0[0] + v0[1] * v0[1]) + (v0[2] * v0[2] + v0[3] * v0[3]) + (v1[0] * v1[0] + v1[1] * v1[1]) + (v1[2] * v1[2] + v1[3] * v1[3]);
                    u32x4 w; w.x = cvt_pk_bf16(v0[0], v0[1]); w.y = cvt_pk_bf16(v0[2], v0[3]); w.z = cvt_pk_bf16(v1[0], v1[1]); w.w = cvt_pk_bf16(v1[2], v1[3]);
                    *(u32x4*)(rowp + bj * HALF) = w;
                }
                if (mode == 3) {
                    s1 += __shfl_xor(s1, 16); s1 += __shfl_xor(s1, 32); s2 += __shfl_xor(s2, 16); s2 += __shfl_xor(s2, 32);
                    if (fq == 0) { float* gp = gvstat + ((size_t)row * 16 + (pn - 16) * 4 + wc) * 2; gp[0] = s1; gp[1] = s2; }
                }
            }
    }
};
template <class Epi, class Sched, bool ALIGN_EPI = false, bool SP2 = false>
__device__ __forceinline__ void gemm_phase(PG8_LAS unsigned char* lds, const Gemm g, const Sched& S, const Epi& E) {
    int tid_l = threadIdx.x; asm volatile("" : "+v"(tid_l));
    int K_l = g.K; asm volatile("" : "+s"(K_l));
    const int tid = tid_l, wid = __builtin_amdgcn_readfirstlane(tid >> 6), lane = tid & 63, wr = wid >> 2, wc = wid & 3, fr = lane & 15, fq = lane >> 4;
    const int K = K_l, nt = K / BK;
    unsigned voffA[2], voffB[2];
#pragma unroll
    for (int i = 0; i < 2; ++i) { int R, C; stage_rc(tid * 16 + i * 8192, R, C); const int Rb = Epi::PERM ? ((R & ~31) + perm32(R & 31)) : R;
        voffA[i] = (unsigned)(R * K + C) * 2u; voffB[i] = (unsigned)(Rb * K + C) * 2u; }
    const size_t kstep = (size_t)(BK * 2);
    const size_t hstep = (size_t)HALF * K * 2;
    const size_t tstep = 2 * hstep;
    const unsigned ldsw = (unsigned)wid * 1024u;
    const int aoff = lds_byte(wr * 64 + fr, fq * 8), boff = lds_byte(wc * 32 + fr, fq * 8);
#define PG8_SA(b, h) (((b) * 2 + (h)) * HTB)
#define PG8_SB(b, h) ((4 + (b) * 2 + (h)) * HTB)
#define PG8_STAGE(bufoff, gbase, voff) do { _Pragma("unroll") for (int _i = 0; _i < 2; ++_i) \
        __builtin_amdgcn_global_load_lds((const unsigned*)((const char*)(gbase) + (voff)[_i]), (PG8_LAS unsigned*)(lds + (bufoff) + ldsw + _i * 8192), 16, 0, 0); } while (0)
#define PG8_LDA(dst, b, h) do { _Pragma("unroll") for (int m = 0; m < 4; ++m) _Pragma("unroll") for (int k = 0; k < 2; ++k) dst[m][k] = *(const PG8_LAS bf16x8*)(lds + PG8_SA(b, h) + aoff + m * 2048 + k * 1024); } while (0)
#define PG8_LDB(dst, b, h) do { _Pragma("unroll") for (int n = 0; n < 2; ++n) _Pragma("unroll") for (int k = 0; k < 2; ++k) dst[n][k] = *(const PG8_LAS bf16x8*)(lds + PG8_SB(b, h) + boff + n * 2048 + k * 1024); } while (0)
#define PG8_MMA(ai, bj, At, Bt) do { __builtin_amdgcn_s_setprio(1); _Pragma("unroll") for (int m = 0; m < 4; ++m) _Pragma("unroll") for (int n = 0; n < 2; ++n) _Pragma("unroll") for (int k = 0; k < 2; ++k) \
        acc[ai][bj][m][n] = __builtin_amdgcn_mfma_f32_16x16x32_bf16(Bt[n][k], At[m][k], acc[ai][bj][m][n], 0, 0, 0); __builtin_amdgcn_s_setprio(0); } while (0)
#define PG8_WAIT_V(n) asm volatile("s_waitcnt vmcnt(" #n ")" ::: "memory")
#define PG8_WAIT_L(n) asm volatile("s_waitcnt lgkmcnt(" #n ")" ::: "memory")
#define PG8_BAR __builtin_amdgcn_s_barrier()
#define PG8_SCHED __builtin_amdgcn_sched_barrier(0)
    Unit cur, nxt; int ui = 0;
    if (!S.next(0, cur)) return;
    f32x4 acc[2][2][4][2];
#pragma unroll
    for (int a = 0; a < 2; ++a)
#pragma unroll
        for (int b = 0; b < 2; ++b)
#pragma unroll
            for (int m = 0; m < 4; ++m)
#pragma unroll
                for (int n = 0; n < 2; ++n) acc[a][b][m][n] = (f32x4){0.f, 0.f, 0.f, 0.f};
    bf16x8 At[4][2], B0[2][2], B1[2][2];
    const char* cA = (const char*)g.A + (size_t)cur.pm * tstep; const char* cB = (const char*)g.Bt + (size_t)cur.pn * tstep;
    S.a_ready(cur);
    if constexpr (SP2) {
        PG8_STAGE(PG8_SB(0, 0), cB, voffB); PG8_STAGE(PG8_SB(0, 1), cB + hstep, voffB); PG8_STAGE(PG8_SA(0, 0), cA, voffA); PG8_STAGE(PG8_SA(0, 1), cA + hstep, voffA);
        if (wr == 1) PG8_BAR;
        PG8_WAIT_V(2); PG8_BAR;
        PG8_STAGE(PG8_SB(1, 0), cB + kstep, voffB); PG8_STAGE(PG8_SA(1, 0), cA + kstep, voffA); PG8_STAGE(PG8_SB(1, 1), cB + hstep + kstep, voffB);
        PG8_WAIT_V(6); PG8_BAR;
    } else {
        PG8_STAGE(PG8_SB(0, 0), cB, voffB); PG8_STAGE(PG8_SA(0, 0), cA, voffA); PG8_STAGE(PG8_SB(0, 1), cB + hstep, voffB); PG8_STAGE(PG8_SA(0, 1), cA + hstep, voffA);
        if (wr == 1) PG8_BAR;
        PG8_WAIT_V(4); PG8_BAR;
        PG8_STAGE(PG8_SB(1, 0), cB + kstep, voffB); PG8_STAGE(PG8_SA(1, 0), cA + kstep, voffA); PG8_STAGE(PG8_SB(1, 1), cB + hstep + kstep, voffB);
        PG8_WAIT_V(6); PG8_BAR;
    }
    for (;;) {
        const bool has_next = S.next(ui + 1, nxt);
        const char* nA = has_next ? (const char*)g.A + (size_t)nxt.pm * tstep : cA; const char* nB = has_next ? (const char*)g.Bt + (size_t)nxt.pn * tstep : cB;
        for (int t = 0; t < nt; t += 2) {
            const bool last = (t == nt - 2);
            const char* a1 = cA + (size_t)(t + 1) * kstep;
            const char* a2 = last ? nA : cA + (size_t)(t + 2) * kstep; const char* b2 = last ? nB : cB + (size_t)(t + 2) * kstep;
            const char* a3 = a2 + kstep; const char* b3 = b2 + kstep;
            if (last && has_next) S.a_ready(nxt);
            if constexpr (SP2) {
            PG8_LDB(B0, 0, 0); PG8_LDB(B1, 0, 1); PG8_SCHED; PG8_LDA(At, 0, 0); PG8_STAGE(PG8_SA(1, 1), a1 + hstep, voffA);
            PG8_WAIT_V(8); PG8_WAIT_L(0); PG8_BAR; PG8_MMA(0, 0, At, B0); PG8_MMA(0, 1, At, B1); PG8_BAR; PG8_SCHED;
            PG8_LDA(At, 0, 1); PG8_STAGE(PG8_SB(0, 0), b2, voffB); PG8_STAGE(PG8_SB(0, 1), b2 + hstep, voffB); PG8_STAGE(PG8_SA(0, 0), a2, voffA);
            PG8_WAIT_V(8); PG8_WAIT_L(0); PG8_BAR; PG8_MMA(1, 0, At, B0); PG8_MMA(1, 1, At, B1); PG8_BAR; PG8_SCHED;
            PG8_LDB(B0, 1, 0); PG8_LDB(B1, 1, 1); PG8_SCHED; PG8_LDA(At, 1, 0); PG8_STAGE(PG8_SA(0, 1), a2 + hstep, voffA);
            PG8_WAIT_V(8); PG8_WAIT_L(0); PG8_BAR; PG8_MMA(0, 0, At, B0); PG8_MMA(0, 1, At, B1); PG8_BAR; PG8_SCHED;
            PG8_LDA(At, 1, 1); PG8_STAGE(PG8_SB(1, 0), b3, voffB); PG8_STAGE(PG8_SB(1, 1), b3 + hstep, voffB); PG8_STAGE(PG8_SA(1, 0), a3, voffA);
            PG8_WAIT_V(8); PG8_WAIT_L(0); PG8_BAR; PG8_MMA(1, 0, At, B0); PG8_MMA(1, 1, At, B1); PG8_BAR; PG8_SCHED;
            } else {
            PG8_LDB(B0, 0, 0); PG8_SCHED; PG8_LDA(At, 0, 0); PG8_STAGE(PG8_SA(1, 1), a1 + hstep, voffA);
            PG8_WAIT_L(8); PG8_BAR; PG8_WAIT_L(0); PG8_MMA(0, 0, At, B0); PG8_BAR; PG8_SCHED;
            PG8_LDB(B1, 0, 1); PG8_STAGE(PG8_SB(0, 0), b2, voffB);
            PG8_BAR; PG8_WAIT_L(0); PG8_MMA(0, 1, At, B1); PG8_BAR;
            PG8_LDA(At, 0, 1); PG8_STAGE(PG8_SA(0, 0), a2, voffA);
            PG8_BAR; PG8_WAIT_L(0); PG8_MMA(1, 0, At, B0); PG8_BAR; PG8_SCHED;
            PG8_STAGE(PG8_SB(0, 1), b2 + hstep, voffB);
            PG8_WAIT_V(6); PG8_BAR; PG8_MMA(1, 1, At, B1); PG8_BAR;
            PG8_LDB(B0, 1, 0); PG8_SCHED; PG8_LDA(At, 1, 0); PG8_STAGE(PG8_SA(0, 1), a2 + hstep, voffA);
            PG8_WAIT_L(8); PG8_BAR; PG8_WAIT_L(0); PG8_MMA(0, 0, At, B0); PG8_BAR; PG8_SCHED;
            PG8_LDB(B1, 1, 1); PG8_STAGE(PG8_SB(1, 0), b3, voffB);
            PG8_BAR; PG8_WAIT_L(0); PG8_MMA(0, 1, At, B1); PG8_BAR;
            PG8_LDA(At, 1, 1); PG8_STAGE(PG8_SA(1, 0), a3, voffA);
            PG8_BAR; PG8_WAIT_L(0); PG8_MMA(1, 0, At, B0); PG8_BAR; PG8_SCHED;
            PG8_STAGE(PG8_SB(1, 1), b3 + hstep, voffB);
            PG8_WAIT_V(6); PG8_BAR; PG8_MMA(1, 1, At, B1); PG8_BAR;
            }
        }
        if constexpr (ALIGN_EPI) { if (wr == 0) PG8_BAR; }
        if constexpr (!Epi::AFTER_DRAIN) { E(acc, cur, wr, wc, fr, fq); S.done(cur); }
        if (!has_next) break;
#pragma unroll
        for (int a = 0; a < 2; ++a)
#pragma unroll
            for (int b = 0; b < 2; ++b)
#pragma unroll
                for (int m = 0; m < 4; ++m)
#pragma unroll
                    for (int n = 0; n < 2; ++n) acc[a][b][m][n] = (f32x4){0.f, 0.f, 0.f, 0.f};
        cur = nxt; cA = nA; cB = nB; ++ui;
        if constexpr (ALIGN_EPI) { if (wr == 1) PG8_BAR; }
    }
    PG8_WAIT_V(0);
    if constexpr (!ALIGN_EPI) { if (wr == 0) PG8_BAR; }
    PG8_BAR;
    if constexpr (Epi::AFTER_DRAIN) { E.fused(acc, cur, wr, wc, fr, fq, lds, wid, lane); S.done(cur); }
#undef PG8_SA
#undef PG8_SB
#undef PG8_STAGE
#undef PG8_LDA
#undef PG8_LDB
#undef PG8_MMA
#undef PG8_WAIT_V
#undef PG8_WAIT_L
#undef PG8_BAR
#undef PG8_SCHED
}
}

#define LAS __attribute__((address_space(3)))
typedef unsigned short bf16;
typedef float f32x4 __attribute__((ext_vector_type(4)));
typedef float f32x2 __attribute__((ext_vector_type(2)));
typedef unsigned u32x4 __attribute__((ext_vector_type(4)));
typedef unsigned u32x2 __attribute__((ext_vector_type(2)));
typedef short bf16x8 __attribute__((ext_vector_type(8)));

constexpr int NB = 16, SEQ = 2048, D = 2048, T = NB * SEQ, DFF = 5632, NMOD = 9 * D;
constexpr int NPROJ = 5120, NIN = 5128, NIN_PAD = 5376, NGU = 2 * DFF;
constexpr float EPS = 1e-6f;
constexpr size_t MiB = 1u << 20;
constexpr size_t OFF_H0A = 256 * 1024, OFF_H0 = 512 * 1024, OFF_S00 = 768 * 1024;
constexpr size_t OFF_GX = 2304 * 1024, OFF_UX = 2688 * 1024, OFF_YP = 3072 * 1024;
constexpr size_t OFF_MOD = 1 * MiB, OFF_YSSQ = 4 * MiB, OFF_GVSTAT = 8 * MiB, OFF_HSSQ = 12 * MiB, OFF_G = 14 * MiB;
constexpr size_t OFF_WGU0 = 16 * MiB, OFF_WD0 = 60 * MiB, OFF_WGU1 = 82 * MiB, OFF_WD1 = 126 * MiB, OFF_WIN = 148 * MiB, OFF_WOUT = 169 * MiB;
constexpr size_t OFF_H = 192 * MiB, OFF_Y = 320 * MiB, OFF_ACT = 448 * MiB, WS_END = 800 * MiB;
constexpr int LDS_BYTES = 155648;
constexpr int LDP = 136;

__device__ __forceinline__ unsigned short f2bf(float f) { unsigned u = __float_as_uint(f); return (unsigned short)((u + 0x7fffu + ((u >> 16) & 1u)) >> 16); }
__device__ __forceinline__ unsigned pk2(float lo, float hi) { return pg8::cvt_pk_bf16(lo, hi); }
__device__ __forceinline__ float bflo(unsigned w) { return __uint_as_float(w << 16); }
__device__ __forceinline__ float bfhi(unsigned w) { return __uint_as_float(w & 0xffff0000u); }
__device__ __forceinline__ float wave_sum(float v) {
#pragma unroll
    for (int o = 1; o < 64; o <<= 1) v += __shfl_xor(v, o);
    return v;
}
#define LDS_WAIT() asm volatile("s_waitcnt lgkmcnt(0)" ::: "memory")
__device__ __forceinline__ bf16x8 frag(const LAS unsigned char* base, int row, int kcol) { return *(const LAS bf16x8*)(base + (row * LDP + kcol) * 2); }
#define MFMA16(a, b, c) __builtin_amdgcn_mfma_f32_16x16x32_bf16((a), (b), (c), 0, 0, 0)

__device__ __forceinline__ void transpose_item(const float* __restrict__ W, int N, int k0, int src4, bf16* __restrict__ WT, int K, int dstrow0, LAS float* scr, int lane) {
    const int lr = lane >> 4, c4 = lane & 15;
#pragma unroll
    for (int i = 0; i < 16; ++i) { const int kk = 4 * i + lr;
        const f32x4 v = src4 >= 0 ? __builtin_nontemporal_load((const f32x4*)(W + (size_t)(k0 + kk) * N + src4)) : (f32x4){0.f, 0.f, 0.f, 0.f};
        LAS float* d = scr + kk * 65 + 4 * c4; d[0] = v[0]; d[1] = v[1]; d[2] = v[2]; d[3] = v[3]; }
    LDS_WAIT();
    const int c = lane & 7;
#pragma unroll
    for (int j = 0; j < 8; ++j) { const int n = (lane >> 3) + 8 * j; const LAS float* sp = scr + (8 * c) * 65 + n;
        u32x4 o; o.x = pk2(sp[0 * 65], sp[1 * 65]); o.y = pk2(sp[2 * 65], sp[3 * 65]); o.z = pk2(sp[4 * 65], sp[5 * 65]); o.w = pk2(sp[6 * 65], sp[7 * 65]);
        *(u32x4*)(WT + (size_t)(dstrow0 + n) * K + k0 + 8 * c) = o; }
    LDS_WAIT();
}
__device__ __forceinline__ void p0_transposes(const float* const* in, unsigned char* ws, LAS unsigned char* lds, int blk, int nblk, int wid, int lane) {
    LAS float* scr = (LAS float*)(lds + wid * 16640);
    constexpr int IT_FF = 32 * 88, IT_IN = 32 * (NIN_PAD / 64), IT_OUT = 32 * 32, NITEMS = 6 * IT_FF + IT_IN + IT_OUT;
    int ibeg, iend;
    if (nblk == 256) { constexpr int N1 = 70, BASE = 144 * N1, REM = NITEMS - BASE;
        if (blk < 144) { ibeg = blk * N1; iend = ibeg + N1; } else { ibeg = BASE + (int)(((long)(blk - 144) * REM) / 112); iend = BASE + (int)(((long)(blk - 143) * REM) / 112); } }
    else { ibeg = (int)(((long)blk * NITEMS) / nblk); iend = (int)(((long)(blk + 1) * NITEMS) / nblk); }
    const int c4 = 4 * (lane & 15);
    for (int it = ibeg + wid; it < iend; it += 8) {
        if (it < 6 * IT_FF) {
            const int mat = it / IT_FF, r = it - mat * IT_FF, f = mat / 3, kind = mat - 3 * f;
            bf16* wgu = (bf16*)(ws + (f ? OFF_WGU1 : OFF_WGU0)); bf16* wd = (bf16*)(ws + (f ? OFF_WD1 : OFF_WD0));
            if (kind < 2) {
                const float* W = (kind == 0 ? in[6] : in[7]) + (size_t)f * D * DFF;
                const int kb = r / 88, nb = r - kb * 88, n0 = 64 * nb;
                transpose_item(W, DFF, 64 * kb, n0 + c4, wgu, D, 256 * (n0 >> 7) + (n0 & 127) + 128 * kind, scr, lane);
            } else {
                const float* W = in[8] + (size_t)f * DFF * D;
                const int kb = r >> 5, nb = r & 31;
                transpose_item(W, D, 64 * kb, 64 * nb + c4, wd, DFF, 64 * nb, scr, lane);
            }
        } else {
            int r = it - 6 * IT_FF;
            if (r < IT_IN) {
                const int nblk2 = NIN_PAD / 64, kb = r / nblk2, nb = r - kb * nblk2, d = 64 * nb + c4;
                const int src = d < 3072 ? d : (d < 5120 ? d + 8 : (d < 5128 ? d - 2048 : -1));
                transpose_item(in[9], NIN, 64 * kb, src, (bf16*)(ws + OFF_WIN), D, 64 * nb, scr, lane);
            } else {
                r -= IT_IN; const int kb = r >> 5, nb = r & 31;
                transpose_item(in[19], D, 64 * kb, 64 * nb + c4, (bf16*)(ws + OFF_WOUT), D, 64 * nb, scr, lane);
            }
        }
    }
}
template <int MODE, int CPL, int UNR>
__device__ __forceinline__ void gemv16_item(const float* __restrict__ A, const float* __restrict__ Bv, int lda, const float* __restrict__ W, int ldw, int n0, int cbeg, int cend,
                                            const float* __restrict__ bias, float* __restrict__ out, int ldo, LAS unsigned char* lds, int tid, int wid, int lane) {
    typedef float vt __attribute__((ext_vector_type(CPL)));
    constexpr int NC = 64 * CPL;
    LAS float* sw = (LAS float*)(lds + wid * 4096);
    LAS float* red = (LAS float*)(lds + 32768);
    vt acc[16];
#pragma unroll
    for (int b = 0; b < 16; ++b) acc[b] = (vt)(0.f);
    for (int c = cbeg + wid; c < cend; c += 8) {
        const int k0 = c * 64;
#pragma unroll
        for (int b = 0; b < 16; ++b) { const float v = A[(size_t)b * lda + k0 + lane]; float f;
            if (MODE == 0) f = v / (1.0f + __expf(-v)); else if (MODE == 1) f = v; else f = v / (1.0f + expf(-v)) * Bv[(size_t)b * lda + k0 + lane];
            sw[lane * 16 + b] = f; }
        LDS_WAIT();
#pragma unroll UNR
        for (int kk = 0; kk < 64; ++kk) {
            const vt wv = __builtin_nontemporal_load((const vt*)(W + (size_t)(k0 + kk) * ldw + n0 + CPL * lane));
            const LAS f32x4* sp = (const LAS f32x4*)(sw + kk * 16);
            const f32x4 s0 = sp[0], s1 = sp[1], s2 = sp[2], s3 = sp[3];
            acc[0] += wv * s0[0]; acc[1] += wv * s0[1]; acc[2] += wv * s0[2]; acc[3] += wv * s0[3];
            acc[4] += wv * s1[0]; acc[5] += wv * s1[1]; acc[6] += wv * s1[2]; acc[7] += wv * s1[3];
            acc[8] += wv * s2[0]; acc[9] += wv * s2[1]; acc[10] += wv * s2[2]; acc[11] += wv * s2[3];
            acc[12] += wv * s3[0]; acc[13] += wv * s3[1]; acc[14] += wv * s3[2]; acc[15] += wv * s3[3];
        }
        LDS_WAIT();
    }
#pragma unroll
    for (int b = 0; b < 16; ++b) *(LAS vt*)(red + (wid * 16 + b) * NC + CPL * lane) = acc[b];
    __syncthreads();
#pragma unroll
    for (int i = 0; i < 2 * CPL; ++i) { const int o = tid + 512 * i, b = o / NC, n = o % NC; float sacc = bias ? bias[n0 + n] : 0.f;
#pragma unroll
        for (int w = 0; w < 8; ++w) sacc += red[(w * 16 + b) * NC + n];
        out[(size_t)b * ldo + n0 + n] = sacc; }
    __syncthreads();
}

#ifndef EXACT_FFN0
#define EXACT_FFN0 0
#endif
__device__ __forceinline__ void row_pass(int k, const float* __restrict__ x, float* out, const bf16* __restrict__ Y, const float* __restrict__ yssq, const float* __restrict__ mod,
                                         const float* __restrict__ g_pre, const float* __restrict__ g_post, bf16* __restrict__ H, float* __restrict__ H0, float* __restrict__ H0A, const float* __restrict__ YP, LAS unsigned char* lds, int wid, int gw, int NGW, int lane) {
    int rbeg, rend, rstep;
    if ((NGW % NB) == 0 && (SEQ % (NGW / NB)) == 0) { const int wpb = NGW / NB, b0 = gw / wpb, wl = gw - b0 * wpb; rbeg = b0 * SEQ + wl; rend = (b0 + 1) * SEQ; rstep = wpb; }
    else { const int rpw = (T + NGW - 1) / NGW; rbeg = gw * rpw; rend = (rbeg + rpw < T) ? rbeg + rpw : T; rstep = 1; }
    if (rbeg >= rend) return;
    LAS f32x4* AVL = (LAS f32x4*)(lds + wid * 16384); LAS f32x4* SHL = (LAS f32x4*)(lds + wid * 16384 + 8192);
    const float* xin_base = (k <= 1) ? x : out;
    const int jj = k - 1;
    const float coef = (jj == 1) ? 1.0f : 0.5f;
    int cur_b = -1;
    f32x4 cg[8];
    f32x4 xn[8]; u32x2 yn[8]; float pn = 0.f;
#pragma unroll
    for (int i = 0; i < 8; ++i) { cg[i] = (f32x4){0.f, 0.f, 0.f, 0.f}; yn[i] = (u32x2){0u, 0u}; }
#define RP_LOAD(r_) do { _Pragma("unroll") for (int i = 0; i < 8; ++i) { const int d_ = 4 * (lane + 64 * i); \
        xn[i] = __builtin_nontemporal_load((const f32x4*)(xin_base + (size_t)(r_) * D + d_)); if (k > 0) yn[i] = __builtin_nontemporal_load((const u32x2*)(Y + (size_t)(r_) * D + d_)); } \
        if (k > 0) pn = lane < 32 ? yssq[(size_t)(r_) * 32 + lane] : 0.f; } while (0)
    RP_LOAD(rbeg);
    for (int r = rbeg; r < rend; r += rstep) {
        f32x4 xv[8]; u32x2 yw[8]; float p = pn;
#pragma unroll
        for (int i = 0; i < 8; ++i) { xv[i] = xn[i]; yw[i] = yn[i]; }
        if (r + rstep < rend) RP_LOAD(r + rstep);
        const int b = r >> 11;
        if (b != cur_b) {
            cur_b = b;
#pragma unroll
            for (int i = 0; i < 8; ++i) { const int d = 4 * (lane + 64 * i);
                if (k > 0) { const f32x4 gt = *(const f32x4*)(mod + (size_t)b * NMOD + (jj * 3 + 2) * D + d); const f32x4 gp = *(const f32x4*)(g_post + jj * D + d); cg[i] = gt * gp * coef; }
                if (k < 3) { const f32x4 gp = *(const f32x4*)(g_pre + k * D + d); const f32x4 sc = *(const f32x4*)(mod + (size_t)b * NMOD + (k * 3 + 1) * D + d);
                    AVL[lane + 64 * i] = gp * (sc + 1.0f); SHL[lane + 64 * i] = *(const f32x4*)(mod + (size_t)b * NMOD + (k * 3 + 0) * D + d); } }
            LDS_WAIT();
        }
        float ss = 0.f;
        if (EXACT_FFN0 && k == 1 && (r & (SEQ - 1)) == 0) {
            f32x4 ye[8]; float pe = 0.f;
#pragma unroll
            for (int i = 0; i < 8; ++i) { const int d = 4 * (lane + 64 * i); const float* yp = YP + (size_t)b * D + d;
                ye[i] = ((*(const f32x4*)yp + *(const f32x4*)(yp + 16 * D)) + (*(const f32x4*)(yp + 32 * D) + *(const f32x4*)(yp + 48 * D)))
                      + ((*(const f32x4*)(yp + 64 * D) + *(const f32x4*)(yp + 80 * D)) + (*(const f32x4*)(yp + 96 * D) + *(const f32x4*)(yp + 112 * D)));
                pe += (ye[i][0] * ye[i][0] + ye[i][1] * ye[i][1]) + (ye[i][2] * ye[i][2] + ye[i][3] * ye[i][3]); }
            pe = wave_sum(pe); const float rstd_y = 1.0f / sqrtf(pe * (1.0f / D) + EPS);
#pragma unroll
            for (int i = 0; i < 8; ++i) { const int d = 4 * (lane + 64 * i);
                const f32x4 v = xv[i] + cg[i] * rstd_y * ye[i];
                __builtin_nontemporal_store(v, (f32x4*)(out + (size_t)r * D + d)); xv[i] = v; }
        } else if (k > 0) {
            p = wave_sum(p); const float rstd_y = 1.0f / sqrtf(p * (1.0f / D) + EPS);
#pragma unroll
            for (int i = 0; i < 8; ++i) { const int d = 4 * (lane + 64 * i);
                f32x4 v = xv[i]; const f32x4 c = cg[i] * rstd_y;
                v[0] += c[0] * bflo(yw[i].x); v[1] += c[1] * bfhi(yw[i].x); v[2] += c[2] * bflo(yw[i].y); v[3] += c[3] * bfhi(yw[i].y);
                __builtin_nontemporal_store(v, (f32x4*)(out + (size_t)r * D + d)); xv[i] = v; }
        }
        if (k < 3) {
#pragma unroll
            for (int i = 0; i < 8; ++i) { const f32x4 v = xv[i]; ss += (v[0] * v[0] + v[1] * v[1]) + (v[2] * v[2] + v[3] * v[3]); }
            ss = wave_sum(ss);
            const float rstd = 1.0f / sqrtf(ss * (1.0f / D) + EPS);
            const bool keep = (k == 1 || (EXACT_FFN0 && k == 0)) && ((r & (SEQ - 1)) == 0);
#pragma unroll
            for (int i = 0; i < 8; ++i) { const int d = 4 * (lane + 64 * i);
                const f32x4 hf = xv[i] * rstd * AVL[lane + 64 * i] + SHL[lane + 64 * i];
                u32x2 o; o.x = pk2(hf[0], hf[1]); o.y = pk2(hf[2], hf[3]);
                *(u32x2*)(H + (size_t)r * D + d) = o;
                if (keep) *(f32x4*)((k == 0 ? H0A : H0) + (size_t)b * D + d) = hf; }
        }
    }
#undef RP_LOAD
}

__device__ __forceinline__ void gate_unit(int pm, const bf16* __restrict__ H, const bf16* __restrict__ Wg, const float* __restrict__ b_i, const float* __restrict__ b_f, float* __restrict__ G, int w, int lane) {
    const int fr = lane & 15, fq = lane >> 4;
    const bf16* a0 = H + (size_t)(pm * 256 + 32 * w + fr) * D + 8 * fq;
    const bf16* a1 = a0 + (size_t)16 * D;
    const bf16* bp = Wg + (size_t)(fr & 7) * D + 8 * fq;
    f32x4 acc0 = (f32x4){0.f, 0.f, 0.f, 0.f}, acc1 = acc0;
#pragma unroll 8
    for (int ks = 0; ks < 64; ++ks) {
        const bf16x8 bv = *(const bf16x8*)(bp + 32 * ks), x0 = *(const bf16x8*)(a0 + 32 * ks), x1 = *(const bf16x8*)(a1 + 32 * ks);
        acc0 = MFMA16(bv, x0, acc0); acc1 = MFMA16(bv, x1, acc1);
    }
    if (fq < 2) {
        const f32x4 bias = fq == 0 ? *(const f32x4*)b_i : *(const f32x4*)b_f;
        *(f32x4*)(G + (size_t)(pm * 256 + 32 * w + fr) * 8 + 4 * fq) = acc0 + bias;
        *(f32x4*)(G + (size_t)(pm * 256 + 32 * w + 16 + fr) * 8 + 4 * fq) = acc1 + bias;
    }
}
__device__ __forceinline__ void s00_task(int b, int h, const float* __restrict__ H0, const float* __restrict__ w_in, const float* __restrict__ conv_w, const float* __restrict__ conv_b,
                                         float* __restrict__ S00, LAS unsigned char* lds, int tid, int wid, int lane) {
    LAS float* red = (LAS float*)lds;
    LAS float* qk = (LAS float*)(lds + 8192);
    const int col = (lane < 32) ? (128 * h + 4 * lane) : (512 + 128 * h + 4 * (lane - 32));
    const float* hp = H0 + (size_t)b * D + wid * 256;
    const float* wp = w_in + (size_t)(wid * 256) * NIN + col;
    f32x4 acc = (f32x4){0.f, 0.f, 0.f, 0.f};
#pragma unroll 32
    for (int k = 0; k < 256; ++k) { const float hv = hp[k]; const f32x4 wv = *(const f32x4*)(wp + (size_t)k * NIN); acc += wv * hv; }
    *(LAS f32x4*)(red + wid * 256 + 4 * lane) = acc;
    __syncthreads();
    if (tid < 256) {
        float p = 0.f;
#pragma unroll
        for (int w8 = 0; w8 < 8; ++w8) p += red[w8 * 256 + tid];
        const int ch = (tid < 128) ? (128 * h + tid) : (512 + 128 * h + (tid - 128));
        float y = conv_w[3 * 1024 + ch] * p + conv_b[ch];
        y = y / (1.0f + expf(-y));
        if (tid >= 128) y *= 0.08838834764831845f;
        qk[tid] = y;
    }
    __syncthreads();
    if (wid == 0) { float v = qk[lane] * qk[128 + lane] + qk[64 + lane] * qk[192 + lane]; v = wave_sum(v); if (lane == 0) S00[b * 4 + h] = v; }
    __syncthreads();
}

constexpr int ML_QS = 0, ML_KS = 34816, ML_KT = 69632, ML_VT = 104448, ML_CB = 126208, ML_GA = 147968, ML_GB = ML_GA + 512, ML_IS = ML_GB + 512, ML_EMT = ML_IS + 512,
              ML_WL = ML_EMT + 512, ML_TMP = ML_WL + 512, ML_SC = ML_TMP + 512;
static_assert(ML_SC + 64 <= LDS_BYTES, "LDS map");
__device__ __forceinline__ float scan_add(float v, int lane) {
#pragma unroll
    for (int o = 1; o < 64; o <<= 1) { const float t = __shfl_up(v, o); if (lane >= o) v += t; }
    return v;
}
__device__ __forceinline__ float scan_max(float v, int lane) {
#pragma unroll
    for (int o = 1; o < 64; o <<= 1) { const float t = __shfl_up(v, o); if (lane >= o) v = fmaxf(v, t); }
    return v;
}
__device__ __forceinline__ float logsig(float v) { return fminf(v, 0.f) - __logf(1.0f + __expf(-fabsf(v))); }
__device__ __forceinline__ void mlstm_item(int b, int h, int sl, const bf16* __restrict__ PROJ, const float* __restrict__ G, const float* __restrict__ conv_w, const float* __restrict__ conv_b,
                                           bf16* __restrict__ MIX, float* __restrict__ HSSQ, const float* __restrict__ S00, LAS unsigned char* lds, int tid, int w, int lane) {
    const int fr = lane & 15, fq = lane >> 4;
    LAS bf16* QS = (LAS bf16*)(lds + ML_QS); LAS bf16* KS = (LAS bf16*)(lds + ML_KS); LAS bf16* KT = (LAS bf16*)(lds + ML_KT);
    LAS bf16* VT = (LAS bf16*)(lds + ML_VT); LAS bf16* CB = (LAS bf16*)(lds + ML_CB);
    LAS float* GA = (LAS float*)(lds + ML_GA); LAS float* GB = (LAS float*)(lds + ML_GB); LAS float* IS = (LAS float*)(lds + ML_IS);
    LAS float* EMT = (LAS float*)(lds + ML_EMT); LAS float* WL = (LAS float*)(lds + ML_WL); LAS float* SC = (LAS float*)(lds + ML_SC);
    f32x4 st[5];
#pragma unroll
    for (int e = 0; e < 5; ++e) st[e] = (f32x4){0.f, 0.f, 0.f, 0.f};
    float m_prev = 0.f;
    for (int i = tid; i < 80 * LDP / 2; i += 512) ((LAS unsigned*)CB)[i] = 0u;
    for (int i = tid; i < 16 * LDP; i += 512) VT[64 * LDP + i] = (i < LDP) ? (bf16)0x3F80 : (bf16)0;
    __syncthreads();
    const int cgi = tid & 31, isk = cgi >> 4, cg8 = cgi & 15, t0 = 8 * (tid >> 5);
    const int colp = isk * 512 + h * 128 + 8 * cg8;
    u32x4 raw[11]; u32x4 vraw[2]; float gpre[4] = {0.f, 0.f, 0.f, 0.f};
#define ML_LOAD(c_) do { const int rl_ = b * SEQ + (c_) * 128; \
        _Pragma("unroll") for (int i = 0; i < 11; ++i) { const int tt = t0 - 3 + i; \
            raw[i] = ((c_) > 0 || tt >= 0) ? *(const u32x4*)(PROJ + (size_t)(rl_ + tt) * NPROJ + colp) : (u32x4){0u, 0u, 0u, 0u}; } \
        _Pragma("unroll") for (int i = 0; i < 2; ++i) { const int idx = tid + 512 * i; \
            vraw[i] = *(const u32x4*)(PROJ + (size_t)(rl_ + (idx >> 3)) * NPROJ + 1024 + h * 256 + sl * 64 + 8 * (idx & 7)); } \
        if (w == 0) { gpre[0] = G[(size_t)(rl_ + lane) * 8 + h]; gpre[1] = G[(size_t)(rl_ + lane) * 8 + 4 + h]; \
                      gpre[2] = G[(size_t)(rl_ + 64 + lane) * 8 + h]; gpre[3] = G[(size_t)(rl_ + 64 + lane) * 8 + 4 + h]; } } while (0)
    ML_LOAD(0);
    for (int c = 0; c < 16; ++c) {
        const int r0 = b * SEQ + c * 128;
        if (w == 0) {
            const float ig1 = gpre[0], fg1 = gpre[1], ig2 = gpre[2], fg2 = gpre[3];
            const float bc1 = scan_add(logsig(fg1), lane); const float tot1 = __shfl(bc1, 63);
            const float bc2 = scan_add(logsig(fg2), lane) + tot1;
            const float ga1 = ig1 - bc1, ga2 = ig2 - bc2;
            const float pm1 = scan_max(ga1, lane); const float pmt = __shfl(pm1, 63);
            const float pm2 = fmaxf(scan_max(ga2, lane), pmt);
            const float b_last = __shfl(bc2, 63), amax = __shfl(pm2, 63);
            const float m_loc = b_last + amax, m_new = fmaxf(b_last + m_prev, m_loc), s_fac = expf(m_loc - m_new);
            { const float m_inter = bc1 + m_prev, m_t = fmaxf(m_inter, bc1 + pm1);
              IS[lane] = expf(m_inter - m_t); GB[lane] = bc1 - m_t; EMT[lane] = expf(-m_t); GA[lane] = ga1; WL[lane] = s_fac * expf(ga1 - amax); }
            { const float m_inter = bc2 + m_prev, m_t = fmaxf(m_inter, bc2 + pm2);
              IS[64 + lane] = expf(m_inter - m_t); GB[64 + lane] = bc2 - m_t; EMT[64 + lane] = expf(-m_t); GA[64 + lane] = ga2; WL[64 + lane] = s_fac * expf(ga2 - amax); }
            if (lane == 63) { SC[0] = b_last; SC[1] = amax; }
        }
#pragma unroll
        for (int i = 0; i < 2; ++i) {
            const int idx = tid + 512 * i, s = idx >> 3, eg = idx & 7; const u32x4 rv = vraw[i];
            LAS bf16* vp = VT + (8 * eg) * LDP + s;
            vp[0 * LDP] = (bf16)(rv.x & 0xffffu); vp[1 * LDP] = (bf16)(rv.x >> 16); vp[2 * LDP] = (bf16)(rv.y & 0xffffu); vp[3 * LDP] = (bf16)(rv.y >> 16);
            vp[4 * LDP] = (bf16)(rv.z & 0xffffu); vp[5 * LDP] = (bf16)(rv.z >> 16); vp[6 * LDP] = (bf16)(rv.w & 0xffffu); vp[7 * LDP] = (bf16)(rv.w >> 16);
        }
        __syncthreads();
        const float b_last = SC[0], amax = SC[1];
        const float m_loc = b_last + amax, m_new = fmaxf(b_last + m_prev, m_loc);
        const float a_fac = expf(b_last + m_prev - m_new);
        {
            f32x4 wl0 = (f32x4){0.f, 0.f, 0.f, 0.f}, wl1 = wl0;
            if (isk) { wl0 = *(const LAS f32x4*)(WL + t0); wl1 = *(const LAS f32x4*)(WL + t0 + 4); }
            const float scl = isk ? 0.08838834764831845f : 1.0f;
            LAS bf16* dst = (isk ? KS : QS) + t0 * LDP + 8 * cg8;
            int colw = colp; asm volatile("" : "+v"(colw));
#pragma unroll
            for (int ep = 0; ep < 4; ++ep) {
                float xl[11], xh[11];
#pragma unroll
                for (int i = 0; i < 11; ++i) { const unsigned wd = raw[i][ep]; xl[i] = bflo(wd); xh[i] = bfhi(wd); }
                f32x2 wj[4];
#pragma unroll
                for (int j = 0; j < 4; ++j) wj[j] = *(const f32x2*)(conv_w + j * 1024 + colw + 2 * ep);
                const f32x2 bb = *(const f32x2*)(conv_b + colw + 2 * ep);
                float yl[8], yh[8];
#pragma unroll
                for (int o = 0; o < 8; ++o) {
                    float a0 = bb.x, a1 = bb.y;
#pragma unroll
                    for (int j = 0; j < 4; ++j) { a0 += wj[j].x * xl[o + j]; a1 += wj[j].y * xh[o + j]; }
                    yl[o] = pg8::silu_f(a0) * scl; yh[o] = pg8::silu_f(a1) * scl;
                    *(LAS unsigned*)(dst + o * LDP + 2 * ep) = pk2(yl[o], yh[o]);
                }
                if (isk) {
                    u32x4 k0, k1;
                    k0.x = pk2(yl[0] * wl0[0], yl[1] * wl0[1]); k0.y = pk2(yl[2] * wl0[2], yl[3] * wl0[3]); k0.z = pk2(yl[4] * wl1[0], yl[5] * wl1[1]); k0.w = pk2(yl[6] * wl1[2], yl[7] * wl1[3]);
                    k1.x = pk2(yh[0] * wl0[0], yh[1] * wl0[1]); k1.y = pk2(yh[2] * wl0[2], yh[3] * wl0[3]); k1.z = pk2(yh[4] * wl1[0], yh[5] * wl1[1]); k1.w = pk2(yh[6] * wl1[2], yh[7] * wl1[3]);
                    *(LAS u32x4*)(KT + (8 * cg8 + 2 * ep) * LDP + t0) = k0;
                    *(LAS u32x4*)(KT + (8 * cg8 + 2 * ep + 1) * LDP + t0) = k1;
                }
            }
        }
        if (c + 1 < 16) ML_LOAD(c + 1);
        __syncthreads();
        f32x4 S[8];
#pragma unroll
        for (int s8 = 0; s8 < 8; ++s8) S[s8] = (f32x4){0.f, 0.f, 0.f, 0.f};
#pragma unroll 1
        for (int ks = 0; ks < 4; ++ks) {
            const bf16x8 a = frag(lds + ML_QS, 16 * w + fr, 32 * ks + 8 * fq);
#pragma unroll
            for (int s8 = 0; s8 < 8; ++s8) if (s8 <= w) { const bf16x8 bk = frag(lds + ML_KS, 16 * s8 + fr, 32 * ks + 8 * fq); S[s8] = MFMA16(bk, a, S[s8]); }
        }
        if (c == 0 && tid == 0) S[0][0] = S00[b * 4 + h];
        __syncthreads();
        {
            const int t = 16 * w + fr; const float gb = GB[t];
#pragma unroll
            for (int s8 = 0; s8 < 8; ++s8) {
                const f32x4 ga4 = *(const LAS f32x4*)(GA + 16 * s8 + 4 * fq);
                float pv[4];
#pragma unroll
                for (int j = 0; j < 4; ++j) { const int s = 16 * s8 + 4 * fq + j; pv[j] = (s8 <= w && s <= t) ? S[s8][j] * __expf(gb + ga4[j]) : 0.f; }
                u32x2 o; o.x = pk2(pv[0], pv[1]); o.y = pk2(pv[2], pv[3]);
                *(LAS u32x2*)(KS + t * LDP + 16 * s8 + 4 * fq) = o;
            }
        }
        __syncthreads();
        {
            f32x4 a1[5], a2[5];
#pragma unroll
            for (int e = 0; e < 5; ++e) { a1[e] = (f32x4){0.f, 0.f, 0.f, 0.f}; a2[e] = (f32x4){0.f, 0.f, 0.f, 0.f}; }
#pragma unroll 1
            for (int ks = 0; ks < 4; ++ks) {
                const bf16x8 ap = frag(lds + ML_KS, 16 * w + fr, 32 * ks + 8 * fq), aq = frag(lds + ML_QS, 16 * w + fr, 32 * ks + 8 * fq);
#pragma unroll
                for (int e = 0; e < 5; ++e) {
                    const bf16x8 bv = frag(lds + ML_VT, 16 * e + fr, 32 * ks + 8 * fq), bcb = frag(lds + ML_CB, 16 * e + fr, 32 * ks + 8 * fq);
                    a1[e] = MFMA16(bv, ap, a1[e]); a2[e] = MFMA16(bcb, aq, a2[e]);
                }
            }
            const int t = 16 * w + fr; const float isv = IS[t], emt = EMT[t];
            const float den0 = isv * a2[4][0] + a1[4][0];
            const float den = __shfl(den0, fr);
            const float inv = 1.0f / fmaxf(fabsf(den), emt);
            float ssq = 0.f;
            bf16* op = MIX + (size_t)(r0 + t) * D + h * 256 + sl * 64 + 4 * fq;
#pragma unroll
            for (int e = 0; e < 4; ++e) {
                const float h0 = (isv * a2[e][0] + a1[e][0]) * inv, h1 = (isv * a2[e][1] + a1[e][1]) * inv, h2 = (isv * a2[e][2] + a1[e][2]) * inv, h3 = (isv * a2[e][3] + a1[e][3]) * inv;
                ssq += (h0 * h0 + h1 * h1) + (h2 * h2 + h3 * h3);
                u32x2 o; o.x = pk2(h0, h1); o.y = pk2(h2, h3);
                *(u32x2*)(op + 16 * e) = o;
            }
            ssq += __shfl_xor(ssq, 16); ssq += __shfl_xor(ssq, 32);
            if (fq == 0) HSSQ[(size_t)(r0 + t) * 16 + 4 * h + sl] = ssq;
        }
        __syncthreads();
#pragma unroll
        for (int e = 0; e < 5; ++e) st[e] = st[e] * a_fac;
#pragma unroll
        for (int ks = 0; ks < 4; ++ks) {
            const bf16x8 bk = frag(lds + ML_KT, 16 * w + fr, 32 * ks + 8 * fq);
#pragma unroll
            for (int e = 0; e < 5; ++e) { const bf16x8 av = frag(lds + ML_VT, 16 * e + fr, 32 * ks + 8 * fq); st[e] = MFMA16(bk, av, st[e]); }
        }
#pragma unroll
        for (int e = 0; e < 5; ++e) { u32x2 o; o.x = pk2(st[e][0], st[e][1]); o.y = pk2(st[e][2], st[e][3]);
            *(LAS u32x2*)(CB + (16 * e + fr) * LDP + 16 * w + 4 * fq) = o; }
        m_prev = m_new;
        __syncthreads();
    }
}

constexpr int SG_WS = 0, SG_VP = 34816, SG_MU = 69632, SG_RS = SG_MU + 512;
__device__ __forceinline__ bool sg_item_of(int q, int blk, int nblk, int& g, int& r0) {
    int pair;
    if ((nblk % 8) == 0) { g = blk & 7; pair = (blk >> 3) + (nblk >> 3) * q; if (pair >= 256) return false; }
    else { const int it = blk + nblk * q; if (it >= 8 * 256) return false; g = it & 7; pair = it >> 3; }
    r0 = (pair >> 4) * SEQ + (pair & 15) * 128; return true;
}
__device__ __forceinline__ void sg_items(int blk, int nblk, const bf16* __restrict__ PROJ, const float* __restrict__ gvstat, const float* __restrict__ ln_g, const float* __restrict__ ln_b,
                                         const float* __restrict__ w_sp, const float* __restrict__ b_sp, bf16* __restrict__ MIX, LAS unsigned char* lds, int tid, int w, int lane) {
    const int fr = lane & 15, fq = lane >> 4;
    LAS bf16* WS = (LAS bf16*)(lds + SG_WS); LAS bf16* VP = (LAS bf16*)(lds + SG_VP); LAS float* MU = (LAS float*)(lds + SG_MU); LAS float* RS = (LAS float*)(lds + SG_RS);
    int cur_g = -1, g, r0;
    if (!sg_item_of(0, blk, nblk, g, r0)) return;
    f32x4 stn[2]; u32x4 rawn[4]; u32x2 uwn[8];
#define SG_LOAD(g_, r0_) do { \
        const f32x4* gp_ = (const f32x4*)(gvstat + (size_t)((r0_) + (tid >> 2)) * 32) + 2 * (tid & 3); stn[0] = gp_[0]; stn[1] = gp_[1]; \
        _Pragma("unroll") for (int i = 0; i < 4; ++i) { const int idx = tid + 512 * i; rawn[i] = *(const u32x4*)(PROJ + (size_t)((r0_) + (idx >> 4)) * NPROJ + 4096 + 128 * (g_) + 8 * (idx & 15)); } \
        const bf16* up_ = PROJ + (size_t)((r0_) + 16 * w + fr) * NPROJ + 3072 + 128 * (g_) + 4 * fq; \
        _Pragma("unroll") for (int ct = 0; ct < 8; ++ct) uwn[ct] = *(const u32x2*)(up_ + 16 * ct); } while (0)
    SG_LOAD(g, r0);
    for (int q = 0;; ++q) {
        if (g != cur_g) {
            __syncthreads();
            for (int idx = tid; idx < 128 * 32; idx += 512) { const int t = idx >> 5, s0 = 4 * (idx & 31);
                f32x4 v = *(const f32x4*)(w_sp + (size_t)(g * 128 + t) * 128 + s0);
                u32x2 o; o.x = pk2(s0 <= t ? v[0] : 0.f, s0 + 1 <= t ? v[1] : 0.f); o.y = pk2(s0 + 2 <= t ? v[2] : 0.f, s0 + 3 <= t ? v[3] : 0.f);
                *(LAS u32x2*)(WS + t * LDP + s0) = o; }
            cur_g = g;
        }
        {
            float s1 = (stn[0][0] + stn[0][2]) + (stn[1][0] + stn[1][2]), s2 = (stn[0][1] + stn[0][3]) + (stn[1][1] + stn[1][3]);
            s1 += __shfl_xor(s1, 1); s2 += __shfl_xor(s2, 1); s1 += __shfl_xor(s1, 2); s2 += __shfl_xor(s2, 2);
            const float mean = s1 * (1.0f / 1024.0f), var = fmaxf(s2 * (1.0f / 1024.0f) - mean * mean, 0.f);
            if ((tid & 3) == 0) { MU[tid >> 2] = mean; RS[tid >> 2] = 1.0f / sqrtf(var + EPS); }
        }
        u32x2 uw[8];
#pragma unroll
        for (int ct = 0; ct < 8; ++ct) uw[ct] = uwn[ct];
        __syncthreads();
#pragma unroll
        for (int i = 0; i < 4; ++i) {
            const int idx = tid + 512 * i, s = idx >> 4, cg8 = idx & 15, ch = 128 * g + 8 * cg8;
            const u32x4 raw = rawn[i];
            const f32x4 g0 = *(const f32x4*)(ln_g + ch), g1 = *(const f32x4*)(ln_g + ch + 4), c0 = *(const f32x4*)(ln_b + ch), c1 = *(const f32x4*)(ln_b + ch + 4);
            const float mu = MU[s], rs = RS[s];
            LAS bf16* vp = VP + (8 * cg8) * LDP + s;
            vp[0 * LDP] = f2bf((bflo(raw.x) - mu) * rs * g0[0] + c0[0]); vp[1 * LDP] = f2bf((bfhi(raw.x) - mu) * rs * g0[1] + c0[1]);
            vp[2 * LDP] = f2bf((bflo(raw.y) - mu) * rs * g0[2] + c0[2]); vp[3 * LDP] = f2bf((bfhi(raw.y) - mu) * rs * g0[3] + c0[3]);
            vp[4 * LDP] = f2bf((bflo(raw.z) - mu) * rs * g1[0] + c1[0]); vp[5 * LDP] = f2bf((bfhi(raw.z) - mu) * rs * g1[1] + c1[1]);
            vp[6 * LDP] = f2bf((bflo(raw.w) - mu) * rs * g1[2] + c1[2]); vp[7 * LDP] = f2bf((bfhi(raw.w) - mu) * rs * g1[3] + c1[3]);
        }
        const int gc = g, rc = r0;
        const bool more = sg_item_of(q + 1, blk, nblk, g, r0);
        if (more) SG_LOAD(g, r0);
        __syncthreads();
        f32x4 z[8];
#pragma unroll
        for (int ct = 0; ct < 8; ++ct) z[ct] = (f32x4){0.f, 0.f, 0.f, 0.f};
#pragma unroll
        for (int ks = 0; ks < 4; ++ks) {
            const bf16x8 a = frag(lds + SG_WS, 16 * w + fr, 32 * ks + 8 * fq);
#pragma unroll
            for (int ct = 0; ct < 8; ++ct) { const bf16x8 bv = frag(lds + SG_VP, 16 * ct + fr, 32 * ks + 8 * fq); z[ct] = MFMA16(bv, a, z[ct]); }
        }
        const int t = 16 * w + fr; const float bs = b_sp[gc * 128 + t];
        bf16* op = MIX + (size_t)(rc + t) * D + 1024 + 128 * gc + 4 * fq;
#pragma unroll
        for (int ct = 0; ct < 8; ++ct) {
            u32x2 o; o.x = pk2(bflo(uw[ct].x) * (z[ct][0] + bs), bfhi(uw[ct].x) * (z[ct][1] + bs)); o.y = pk2(bflo(uw[ct].y) * (z[ct][2] + bs), bfhi(uw[ct].y) * (z[ct][3] + bs));
            *(u32x2*)(op + 16 * ct) = o;
        }
        if (!more) break;
        __syncthreads();
    }
#undef SG_LOAD
}
__device__ __forceinline__ void headnorm_pass(bf16* MIX, const bf16* __restrict__ PROJ, const float* __restrict__ HSSQ, const float* __restrict__ g_mh, int gw, int NGW, int lane) {
    f32x4 g0[2], g1[2];
#pragma unroll
    for (int i = 0; i < 2; ++i) { const int col = 8 * lane + 512 * i; g0[i] = *(const f32x4*)(g_mh + col); g1[i] = *(const f32x4*)(g_mh + col + 4); }
    for (int r0 = gw; r0 < T; r0 += 2 * NGW) {
        u32x4 hv[2][2], ov[2][2]; f32x4 q[2][2];
#pragma unroll
        for (int j = 0; j < 2; ++j) { const int r = r0 + j * NGW; if (r < T) {
#pragma unroll
            for (int i = 0; i < 2; ++i) { const int col = 8 * lane + 512 * i, hd = col >> 8;
                q[j][i] = *(const f32x4*)(HSSQ + (size_t)r * 16 + 4 * hd);
                hv[j][i] = *(const u32x4*)(MIX + (size_t)r * D + col);
                ov[j][i] = __builtin_nontemporal_load((const u32x4*)(PROJ + (size_t)r * NPROJ + 2048 + col)); } } }
#pragma unroll
        for (int j = 0; j < 2; ++j) { const int r = r0 + j * NGW; if (r < T) {
#pragma unroll
            for (int i = 0; i < 2; ++i) { const int col = 8 * lane + 512 * i;
                const float rstd = 1.0f / sqrtf(((q[j][i][0] + q[j][i][1]) + (q[j][i][2] + q[j][i][3])) * (1.0f / 256.0f) + EPS);
                const u32x4 h = hv[j][i], o4 = ov[j][i]; const f32x4 ga = g0[i] * rstd, gb = g1[i] * rstd;
                u32x4 o;
                o.x = pk2(bflo(h.x) * ga[0] * bflo(o4.x), bfhi(h.x) * ga[1] * bfhi(o4.x));
                o.y = pk2(bflo(h.y) * ga[2] * bflo(o4.y), bfhi(h.y) * ga[3] * bfhi(o4.y));
                o.z = pk2(bflo(h.z) * gb[0] * bflo(o4.z), bfhi(h.z) * gb[1] * bfhi(o4.z));
                o.w = pk2(bflo(h.w) * gb[2] * bflo(o4.w), bfhi(h.w) * gb[3] * bfhi(o4.w));
                *(u32x4*)(MIX + (size_t)r * D + col) = o; } } }
    }
}

#define XB_TMO      128
#define XB_XCNT(j)  (256  + 64 * (j))
#define XB_XSUB(j)  (1280 + 64 * (j))
#define XB_XGEN(j)  (2304 + 64 * (j))
#define XB_TOP      3328
#define XB_TOPGEN   3392
#define XCD_BAR_WORDS 3456
#define XB_SPIN_CAP (1u << 18)

__device__ __forceinline__ unsigned xb_ld(unsigned* p)              { return __hip_atomic_load(p, __ATOMIC_RELAXED, __HIP_MEMORY_SCOPE_AGENT); }
__device__ __forceinline__ unsigned xb_add(unsigned* p, unsigned v) { return __hip_atomic_fetch_add(p, v, __ATOMIC_RELAXED, __HIP_MEMORY_SCOPE_AGENT); }
__device__ __forceinline__ unsigned xb_xcc_id() { return (unsigned)__builtin_amdgcn_s_getreg((3 << 11) | 20) & 0xFu; }
#define XB_SPIN(cond, bar) do { unsigned _sp = 0; while (cond) { __builtin_amdgcn_s_sleep(1); \
    if ((++_sp & 255u) == 0u) { if (xb_ld(&(bar)[XB_TMO])) break; if (_sp > XB_SPIN_CAP) { atomicAdd(&(bar)[XB_TMO], 1u); break; } } } } while (0)

struct XcdBarrier {
    unsigned* bar; unsigned x;
    volatile LAS unsigned* st;
};

__device__ __forceinline__ XcdBarrier xcd_barrier_post(unsigned* bar, volatile LAS unsigned* st) {
    XcdBarrier b; b.bar = bar; b.x = xb_xcc_id(); b.st = st;
    if (threadIdx.x == 0) (void)xb_add(&bar[XB_XCNT(b.x)], 1u);
    return b;
}
__device__ __forceinline__ void xcd_barrier_complete(unsigned* bar, unsigned x, unsigned& nloc, unsigned& nx) {
    const unsigned G = gridDim.x * gridDim.y * gridDim.z;
    unsigned sum, cnt, mine, sp = 0u;
    for (;;) {
        sum = 0u; cnt = 0u; mine = 0u;
#pragma unroll
        for (unsigned j = 0; j < 16; ++j) { const unsigned c = xb_ld(&bar[XB_XCNT(j)]); sum += c; cnt += (c > 0u) ? 1u : 0u; mine = (j == x) ? c : mine; }
        if (sum == G) break;
        __builtin_amdgcn_s_sleep(1);
        if ((++sp & 255u) == 0u) { if (xb_ld(&bar[XB_TMO])) break; if (sp > XB_SPIN_CAP) { atomicAdd(&bar[XB_TMO], 1u); break; } }
    }
    nloc = mine > 0u ? mine : 1u; nx = cnt > 0u ? cnt : 1u;
}

__device__ __forceinline__ void xcd_barrier(const XcdBarrier& b) {
    asm volatile("s_waitcnt vmcnt(0)" ::: "memory");
    __syncthreads();
    if (threadIdx.x == 0) {
        unsigned* bar = b.bar;
        __builtin_amdgcn_s_waitcnt(0);
        unsigned nloc = b.st[0], nx = b.st[1];
        if (nloc == 0u) { xcd_barrier_complete(bar, b.x, nloc, nx); b.st[0] = nloc; b.st[1] = nx; }
        const unsigned old = xb_add(&bar[XB_XSUB(b.x)], 1u);
        const unsigned gen = old / nloc;
        if (old + 1u == (gen + 1u) * nloc) {
            __builtin_amdgcn_fence(__ATOMIC_RELEASE, "agent");
            asm volatile("s_waitcnt vmcnt(0)" ::: "memory");
            const unsigned og = xb_add(&bar[XB_TOP], 1u);
            const unsigned tg = og / nx;
            if (og + 1u == (tg + 1u) * nx) xb_add(&bar[XB_TOPGEN], 1u);
            else XB_SPIN(xb_ld(&bar[XB_TOPGEN]) == tg, bar);
            __builtin_amdgcn_fence(__ATOMIC_ACQUIRE, "agent");
            xb_add(&bar[XB_XGEN(b.x)], 1u);
            asm volatile("s_waitcnt vmcnt(0)" ::: "memory");
        } else {
            XB_SPIN(xb_ld(&bar[XB_XGEN(b.x)]) == gen, bar);
            __builtin_amdgcn_fence(__ATOMIC_ACQUIRE, "agent");
            asm volatile("s_waitcnt vmcnt(0)" ::: "memory");
        }
    }
    __syncthreads();
}

struct Args { const float* in[20]; float* out; unsigned char* ws; };
#ifndef GEMM_REPS
#define GEMM_REPS 1
#endif
#define REPLOOP _Pragma("unroll 1") for (int rep_ = 0; rep_ < GEMM_REPS; ++rep_)
__global__ void __launch_bounds__(512, 2) mega_fwd(Args a) {
    extern __shared__ __attribute__((aligned(16))) unsigned char lds_raw[];
    cg::grid_group grid = cg::this_grid();
    LAS unsigned char* lds = (LAS unsigned char*)lds_raw;
    const int blk = blockIdx.x, G_ = gridDim.x, NGW = G_ * 8;
#define FRESH() int tid = threadIdx.x; asm volatile("" : "+v"(tid)); const int lane = tid & 63, wid = __builtin_amdgcn_readfirstlane(tid >> 6), gw = blk * 8 + wid; (void)lane; (void)gw;
    unsigned char* ws = a.ws;
    float* MOD = (float*)(ws + OFF_MOD); float* YSSQ = (float*)(ws + OFF_YSSQ); float* GVSTAT = (float*)(ws + OFF_GVSTAT); float* HSSQ = (float*)(ws + OFF_HSSQ); float* GT = (float*)(ws + OFF_G);
    float* H0 = (float*)(ws + OFF_H0); float* S00 = (float*)(ws + OFF_S00); float* H0A = (float*)(ws + OFF_H0A);
    float* GX = (float*)(ws + OFF_GX); float* UX = (float*)(ws + OFF_UX); float* YP = (float*)(ws + OFF_YP);
    bf16* Hb = (bf16*)(ws + OFF_H); bf16* Yb = (bf16*)(ws + OFF_Y); bf16* ACT = (bf16*)(ws + OFF_ACT);
    const float* x = a.in[0];
    unsigned* BARW = (unsigned*)ws;
    volatile LAS unsigned* BST = (volatile LAS unsigned*)(lds + LDS_BYTES - 64);
    if (threadIdx.x < 2) BST[threadIdx.x] = 0u;
    if (blk == 0) { for (int i = threadIdx.x; i < XCD_BAR_WORDS; i += 512) __hip_atomic_store(BARW + i, 0u, __ATOMIC_RELAXED, __HIP_MEMORY_SCOPE_AGENT); }

#ifndef NO_P0
    { FRESH();
    if (blk < 144) gemv16_item<0, 2, 8>(a.in[1], nullptr, D, a.in[2], NMOD, 128 * blk, 0, 32, a.in[3], MOD, NMOD, lds, tid, wid, lane);
    else if (G_ < 144) { for (int it = blk; it < 144; it += G_) gemv16_item<0, 2, 8>(a.in[1], nullptr, D, a.in[2], NMOD, 128 * it, 0, 32, a.in[3], MOD, NMOD, lds, tid, wid, lane); }
    p0_transposes(a.in, ws, lds, blk, G_, wid, lane); }
#endif
    grid.sync();
    XcdBarrier xbar = xcd_barrier_post(BARW, BST);
#define GSYNC() xcd_barrier(xbar)
#pragma unroll 1
    for (int k = 0; k < 3; ++k) {
#ifndef NO_ROW
        { FRESH(); row_pass(k, x, a.out, Yb, YSSQ, MOD, a.in[4], a.in[5], Hb, H0, H0A, YP, lds, wid, gw, NGW, lane); }
#endif
        GSYNC();
        if (k != 1) {
            const int f = k >> 1;
#ifndef NO_G1
            { pg8::Gemm g{Hb, (const bf16*)(ws + (f ? OFF_WGU1 : OFF_WGU0)), T, NGU, D}; pg8::StaticOrder S; S.init(T, NGU, G_, blk);
              pg8::EpiSwiglu E{ACT, DFF};
              REPLOOP pg8::gemm_phase<pg8::EpiSwiglu, pg8::StaticOrder, true, true>(lds, g, S, E); }
#endif
            if (EXACT_FFN0 && f == 0) { FRESH(); for (int it = blk; it < 176; it += G_) { const int up = it >= 88, nb = up ? it - 88 : it;
                gemv16_item<1, 1, 64>(H0A, nullptr, D, (up ? a.in[7] : a.in[6]), DFF, 64 * nb, 0, 32, nullptr, up ? UX : GX, DFF, lds, tid, wid, lane); } }
            GSYNC();
#ifndef NO_G2
            { pg8::Gemm g{ACT, (const bf16*)(ws + (f ? OFF_WD1 : OFF_WD0)), T, D, DFF}; pg8::StaticOrder S; S.init(T, D, G_, blk);
              pg8::EpiYStat E{Yb, D, YSSQ};
              REPLOOP pg8::gemm_phase<pg8::EpiYStat, pg8::StaticOrder, true, true>(lds, g, S, E); }
#endif
            if (EXACT_FFN0 && f == 0) { FRESH(); for (int it = G_ - 1 - blk; it < 128; it += G_) { const int q8 = it >> 4, nb = it & 15;
                gemv16_item<2, 2, 32>(GX, UX, DFF, a.in[8], D, 128 * nb, 11 * q8, 11 * q8 + 11, nullptr, YP + (size_t)q8 * 16 * D, D, lds, tid, wid, lane); } }
            GSYNC();
        } else {
#ifndef NO_G3
            { pg8::Gemm g{Hb, (const bf16*)(ws + OFF_WIN), T, NPROJ, D}; pg8::StaticOrder S; S.init(T, NPROJ, G_, blk);
              pg8::EpiProj E{ACT, NPROJ, GVSTAT, GT, a.in[12], a.in[13]};
              REPLOOP pg8::gemm_phase<pg8::EpiProj, pg8::StaticOrder, true, true>(lds, g, S, E); }
#endif
            { FRESH(); for (int u = blk; u < T / 256; u += G_) gate_unit(u, Hb, (const bf16*)(ws + OFF_WIN) + (size_t)NPROJ * D, a.in[12], a.in[13], GT, wid, lane); }
            { FRESH(); for (int task = G_ - 1 - blk; task < 64; task += G_) s00_task(task >> 2, task & 3, H0, a.in[9], a.in[10], a.in[11], S00, lds, tid, wid, lane); }
            GSYNC();
#ifndef NO_ML
#ifndef MIX_REPS
#define MIX_REPS 1
#endif
            _Pragma("unroll 1") for (int mrep = 0; mrep < MIX_REPS; ++mrep) {
            { FRESH(); for (int it = blk; it < 256; it += G_) mlstm_item(it >> 4, (it >> 2) & 3, it & 3, ACT, GT, a.in[10], a.in[11], Hb, HSSQ, S00, lds, tid, wid, lane); }
#endif
#ifndef NO_SG
            { FRESH(); sg_items(blk, G_, ACT, GVSTAT, a.in[15], a.in[16], a.in[17], a.in[18], Hb, lds, tid, wid, lane); }
#endif
            }
            GSYNC();
#ifndef NO_HN
            { FRESH(); headnorm_pass(Hb, ACT, HSSQ, a.in[14], gw, NGW, lane); }
#endif
            GSYNC();
#ifndef NO_G4
            { pg8::Gemm g{Hb, (const bf16*)(ws + OFF_WOUT), T, D, D}; pg8::StaticOrder S; S.init(T, D, G_, blk);
              pg8::EpiYStat E{Yb, D, YSSQ};
              REPLOOP pg8::gemm_phase<pg8::EpiYStat, pg8::StaticOrder, true, true>(lds, g, S, E); }
#endif
            GSYNC();
        }
    }
    { FRESH(); row_pass(3, x, a.out, Yb, YSSQ, MOD, a.in[4], a.in[5], Hb, H0, H0A, YP, lds, wid, gw, NGW, lane); }
}

extern "C" void kernel_launch(void* const* d_in, const int* in_sizes, int n_in, void* d_out, int out_size, void* d_ws, size_t ws_size, hipStream_t stream) {
    static int grid = 0;
    if (grid == 0) {
        if (n_in != 20 || out_size != T * D || ws_size < WS_END) { fprintf(stderr, "kernel_launch: unexpected shapes (n_in %d out %d ws %zu)\n", n_in, out_size, ws_size); grid = -1; return; }
        int dev = 0, cus = 0, per_cu = 0;
        hipGetDevice(&dev); hipDeviceGetAttribute(&cus, hipDeviceAttributeMultiprocessorCount, dev);
        if (hipFuncSetAttribute((const void*)mega_fwd, hipFuncAttributeMaxDynamicSharedMemorySize, LDS_BYTES) != hipSuccess) { fprintf(stderr, "kernel_launch: hipFuncSetAttribute failed\n"); grid = -1; return; }
        if (hipOccupancyMaxActiveBlocksPerMultiprocessor(&per_cu, (const void*)mega_fwd, 512, LDS_BYTES) != hipSuccess || per_cu < 1) { fprintf(stderr, "kernel_launch: occupancy query says %d\n", per_cu); per_cu = 1; }
        (void)hipGetLastError();
        grid = cus * per_cu;
        if (grid < 144) { fprintf(stderr, "kernel_launch: grid %d < 144 workgroups is not supported\n", grid); grid = -1; return; }
        fprintf(stderr, "kernel_launch: grid %d (cus %d x %d)\n", grid, cus, per_cu);
    }
    if (grid < 0) return;
    Args a{};
    for (int i = 0; i < 20; ++i) a.in[i] = (const float*)d_in[i];
    a.out = (float*)d_out; a.ws = (unsigned char*)d_ws;
    void* args[] = {&a};
    hipError_t e = hipLaunchCooperativeKernel((const void*)mega_fwd, dim3(grid), dim3(512), args, LDS_BYTES, stream);
    if (e != hipSuccess) fprintf(stderr, "cooperative launch failed: %s (grid %d)\n", hipGetErrorString(e), grid);
}
```

```cpp
#include <hip/hip_runtime.h>
#include <hip/hip_cooperative_groups.h>
#include <cstdio>
#include <cstdint>
namespace cg = cooperative_groups;
namespace pg8 {
#define PG8_LAS __attribute__((address_space(3)))
typedef unsigned short bf16_t;
typedef short bf16x8 __attribute__((ext_vector_type(8)));
typedef float f32x4 __attribute__((ext_vector_type(4)));
typedef unsigned u32x4 __attribute__((ext_vector_type(4)));
constexpr int BM = 256, BK = 64, HALF = 128, HTB = HALF * BK * 2  , STAGE_BYTES = 8 * HTB, NXCD = 8, WGM = 8;

__host__ __device__ __forceinline__ int lds_byte(int r, int c) { const int st = (r >> 4) * 2 + (c >> 5), rr = r & 15, cc = c & 31, ob = rr * 64 + cc * 2; return st * 1024 + (ob ^ (((ob >> 9) & 1) << 5)); }
__host__ __device__ __forceinline__ void stage_rc(int b, int& R, int& C) { const int st = b / 1024, sb = b % 1024, swz = sb ^ (((sb >> 9) & 1) << 5); R = (st >> 1) * 16 + swz / 64; C = (st & 1) * 32 + (swz % 64) / 2; }
__host__ __device__ __forceinline__ int perm32(int rho) { const int n = rho >> 4, i = rho & 15; return 8 * (i >> 2) + 4 * n + (i & 3); }

struct Unit { int pm, pn; };
struct Gemm { const bf16_t* A; const bf16_t* Bt; int M, N, K; };

struct StaticOrder {
    int nM, nN, nwg, G, c;
    __host__ __device__ void init(int M, int N, int G_, int c_) { nM = M / BM; nN = N / BM; nwg = nM * nN; G = G_; c = c_; }
    __host__ __device__ bool next(int i, Unit& u) const {
        const long L = (long)i * G + c; if (L >= nwg) return false;
        int wgid = (int)L; { const int q = nwg / NXCD, r = nwg % NXCD, xcd = wgid % NXCD, off = wgid / NXCD; wgid = (xcd < r ? xcd * (q + 1) : r * (q + 1) + (xcd - r) * q) + off; }
        const int nig = WGM * nN, gid = wgid / nig, fm = gid * WGM, gsz = (nM - fm) < WGM ? (nM - fm) : WGM;
        u.pm = fm + ((wgid % nig) % gsz); u.pn = (wgid % nig) / gsz; return true;
    }
    __device__ __forceinline__ void a_ready(const Unit&) const {}
    __device__ __forceinline__ void done(const Unit&) const {}
};
__device__ __forceinline__ unsigned cvt_pk_bf16(float lo, float hi) { unsigned r; asm volatile("v_cvt_pk_bf16_f32 %0, %1, %2" : "=v"(r) : "v"(lo), "v"(hi)); return r; }
typedef unsigned u32x2 __attribute__((ext_vector_type(2)));
__device__ __forceinline__ float fast_sigmoid(float v) { return __builtin_amdgcn_rcpf(1.0f + __builtin_amdgcn_exp2f(-1.44269504f * v)); }
__device__ __forceinline__ float silu_f(float v) { return v * fast_sigmoid(v); }
__device__ __forceinline__ float gelu_tanh_f(float v) { const float u = 1.59576912f * (v + 0.044715f * v * v * v); return v * fast_sigmoid(u); }

struct EpiSwiglu {
    static constexpr bool PERM = true, AFTER_DRAIN = false; static constexpr int NST = 8;
    bf16_t* O; int ldc;
    __device__ __forceinline__ void operator()(const f32x4 (&acc)[2][2][4][2], const Unit& u, int wr, int wc, int fr, int fq) const {
        const int row0 = u.pm * BM + wr * 64 + fr, col0 = u.pn * HALF + wc * 32 + 8 * fq;
#pragma unroll
        for (int ai = 0; ai < 2; ++ai)
#pragma unroll
            for (int m = 0; m < 4; ++m) {
                bf16_t* rowp = O + (size_t)(row0 + ai * HALF + m * 16) * ldc + col0;
                const f32x4 g0 = acc[ai][0][m][0], g1 = acc[ai][0][m][1], u0 = acc[ai][1][m][0], u1 = acc[ai][1][m][1];
                u32x4 w;
                w.x = cvt_pk_bf16(silu_f(g0[0]) * u0[0], silu_f(g0[1]) * u0[1]); w.y = cvt_pk_bf16(silu_f(g0[2]) * u0[2], silu_f(g0[3]) * u0[3]);
                w.z = cvt_pk_bf16(silu_f(g1[0]) * u1[0], silu_f(g1[1]) * u1[1]); w.w = cvt_pk_bf16(silu_f(g1[2]) * u1[2], silu_f(g1[3]) * u1[3]);
                *(u32x4*)rowp = w;
            }
    }
};
struct EpiYStat {
    static constexpr bool PERM = true, AFTER_DRAIN = false; static constexpr int NST = 24;
    bf16_t* Y; int ldc; float* ssq;
    __device__ __forceinline__ void operator()(const f32x4 (&acc)[2][2][4][2], const Unit& u, int wr, int wc, int fr, int fq) const {
        const int row0 = u.pm * BM + wr * 64 + fr, col0 = u.pn * BM + wc * 32 + 8 * fq;
#pragma unroll
        for (int ai = 0; ai < 2; ++ai)
#pragma unroll
            for (int m = 0; m < 4; ++m) {
                const int row = row0 + ai * HALF + m * 16;
                bf16_t* rowp = Y + (size_t)row * ldc + col0;
                float s = 0.f;
#pragma unroll
                for (int bj = 0; bj < 2; ++bj) {
                    const f32x4 v0 = acc[ai][bj][m][0], v1 = acc[ai][bj][m][1];
                    s += (v0[0] * v0[0] + v0[1] * v0[1]) + (v0[2] * v0[2] + v0[3] * v0[3]) + (v1[0] * v1[0] + v1[1] * v1[1]) + (v1[2] * v1[2] + v1[3] * v1[3]);
                    u32x4 w; w.x = cvt_pk_bf16(v0[0], v0[1]); w.y = cvt_pk_bf16(v0[2], v0[3]); w.z = cvt_pk_bf16(v1[0], v1[1]); w.w = cvt_pk_bf16(v1[2], v1[3]);
                    *(u32x4*)(rowp + bj * HALF) = w;
                }
                s += __shfl_xor(s, 16); s += __shfl_xor(s, 32);
                if (fq == 0) ssq[(size_t)row * 32 + u.pn * 4 + wc] = s;
            }
    }
};
struct EpiProj {
    static constexpr bool PERM = true, AFTER_DRAIN = false; static constexpr int NST = 16;
    bf16_t* P; int ldc; float* gvstat; float* G; const float* b_i; const float* b_f;
    __device__ __forceinline__ void operator()(const f32x4 (&acc)[2][2][4][2], const Unit& u, int wr, int wc, int fr, int fq) const {
        const int pn = u.pn;
        const int row0 = u.pm * BM + wr * 64 + fr;
        if (pn == 20) {
            if (wc == 0 && fq == 0) {
                const f32x4 bi = *(const f32x4*)b_i, bf = *(const f32x4*)b_f;
#pragma unroll
                for (int ai = 0; ai < 2; ++ai)
#pragma unroll
                    for (int m = 0; m < 4; ++m) {
                        const int row = row0 + ai * HALF + m * 16;
                        *(f32x4*)(G + (size_t)row * 8) = acc[ai][0][m][0] + bi;
                        *(f32x4*)(G + (size_t)row * 8 + 4) = acc[ai][0][m][1] + bf;
                    }
            }
            return;
        }
        const int mode = pn < 8 ? 0 : (pn < 12 ? 1 : (pn < 16 ? 2 : 3));
        const int col0 = pn * BM + wc * 32 + 8 * fq;
#pragma unroll
        for (int ai = 0; ai < 2; ++ai)
#pragma unroll
            for (int m = 0; m < 4; ++m) {
                const int row = row0 + ai * HALF + m * 16;
                bf16_t* rowp = P + (size_t)row * ldc + col0;
                float s1 = 0.f, s2 = 0.f;
#pragma unroll
                for (int bj = 0; bj < 2; ++bj) {
                    f32x4 v0 = acc[ai][bj][m][0], v1 = acc[ai][bj][m][1];
                    if (mode == 1) {
#pragma unroll
                        for (int j = 0; j < 4; ++j) { v0[j] = fast_sigmoid(v0[j]); v1[j] = fast_sigmoid(v1[j]); }
                    } else if (mode >= 2) {
#pragma unroll
                        for (int j = 0; j < 4; ++j) { v0[j] = gelu_tanh_f(v0[j]); v1[j] = gelu_tanh_f(v1[j]); }
                    }
                    s1 += (v0[0] + v0[1]) + (v0[2] + v0[3]) + (v1[0] + v1[1]) + (v1[2] + v1[3]);
                    s2 += (v0[0] * v0[0] + v0[1] * v0[1]) + (v0[2] * v0[2] + v0[3] * v0[3]) + (v1[0] * v1[0] + v1[1] * v1[1]) + (v1[2] * v1[2] + v1[3] * v1[3]);
                    u32x4 w; w.x = cvt_pk_bf16(v0[0], v0[1]); w.y = cvt_pk_bf16(v0[2], v0[3]); w.z = cvt_pk_bf16(v1[0], v1[1]); w.w = cvt_pk_bf16(v1[2], v1[3]);
                    *(u32x4*)(rowp + bj * HALF) = w;
                }
                if (mode == 3) {
                    s1 += __shfl_xor(s1, 16); s1 += __shfl_xor(s1, 32); s2 += __shfl_xor(s2, 16); s2 += __shfl_xor(s2, 32);
                    if (fq == 0) { float* gp = gvstat + ((size_t)row * 16 + (pn - 16) * 4 + wc) * 2; gp[0] = s1; gp[1] = s2; }
                }
            }
    }
};
template <class Epi, class Sched, bool ALIGN_EPI = false, bool SP2 = false>
__device__ __forceinline__ void gemm_phase(PG8_LAS unsigned char* lds, const Gemm g, const Sched& S, const Epi& E) {
    int tid_l = threadIdx.x; asm volatile("" : "+v"(tid_l));
    int K_l = g.K; asm volatile("" : "+s"(K_l));
    const int tid = tid_l, wid = __builtin_amdgcn_readfirstlane(tid >> 6), lane = tid & 63, wr = wid >> 2, wc = wid & 3, fr = lane & 15, fq = lane >> 4;
    const int K = K_l, nt = K / BK;
    unsigned voffA[2], voffB[2];
#pragma unroll
    for (int i = 0; i < 2; ++i) { int R, C; stage_rc(tid * 16 + i * 8192, R, C); const int Rb = Epi::PERM ? ((R & ~31) + perm32(R & 31)) : R;
        voffA[i] = (unsigned)(R * K + C) * 2u; voffB[i] = (unsigned)(Rb * K + C) * 2u; }
    const size_t kstep = (size_t)(BK * 2);
    const size_t hstep = (size_t)HALF * K * 2;
    const size_t tstep = 2 * hstep;
    const unsigned ldsw = (unsigned)wid * 1024u;
    const int aoff = lds_byte(wr * 64 + fr, fq * 8), boff = lds_byte(wc * 32 + fr, fq * 8);
#define PG8_SA(b, h) (((b) * 2 + (h)) * HTB)
#define PG8_SB(b, h) ((4 + (b) * 2 + (h)) * HTB)
#define PG8_STAGE(bufoff, gbase, voff) do { _Pragma("unroll") for (int _i = 0; _i < 2; ++_i) \
        __builtin_amdgcn_global_load_lds((const unsigned*)((const char*)(gbase) + (voff)[_i]), (PG8_LAS unsigned*)(lds + (bufoff) + ldsw + _i * 8192), 16, 0, 0); } while (0)
#define PG8_LDA(dst, b, h) do { _Pragma("unroll") for (int m = 0; m < 4; ++m) _Pragma("unroll") for (int k = 0; k < 2; ++k) dst[m][k] = *(const PG8_LAS bf16x8*)(lds + PG8_SA(b, h) + aoff + m * 2048 + k * 1024); } while (0)
#define PG8_LDB(dst, b, h) do { _Pragma("unroll") for (int n = 0; n < 2; ++n) _Pragma("unroll") for (int k = 0; k < 2; ++k) dst[n][k] = *(const PG8_LAS bf16x8*)(lds + PG8_SB(b, h) + boff + n * 2048 + k * 1024); } while (0)
#define PG8_MMA(ai, bj, At, Bt) do { __builtin_amdgcn_s_setprio(1); _Pragma("unroll") for (int m = 0; m < 4; ++m) _Pragma("unroll") for (int n = 0; n < 2; ++n) _Pragma("unroll") for (int k = 0; k < 2; ++k) \
        acc[ai][bj][m][n] = __builtin_amdgcn_mfma_f32_16x16x32_bf16(Bt[n][k], At[m][k], acc[ai][bj][m][n], 0, 0, 0); __builtin_amdgcn_s_setprio(0); } while (0)
#define PG8_WAIT_V(n) asm volatile("s_waitcnt vmcnt(" #n ")" ::: "memory")
#define PG8_WAIT_L(n) asm volatile("s_waitcnt lgkmcnt(" #n ")" ::: "memory")
#define PG8_BAR __builtin_amdgcn_s_barrier()
#define PG8_SCHED __builtin_amdgcn_sched_barrier(0)
    Unit cur, nxt; int ui = 0;
    if (!S.next(0, cur)) return;
    f32x4 acc[2][2][4][2];
#pragma unroll
    for (int a = 0; a < 2; ++a)
#pragma unroll
        for (int b = 0; b < 2; ++b)
#pragma unroll
            for (int m = 0; m < 4; ++m)
#pragma unroll
                for (int n = 0; n < 2; ++n) acc[a][b][m][n] = (f32x4){0.f, 0.f, 0.f, 0.f};
    bf16x8 At[4][2], B0[2][2], B1[2][2];
    const char* cA = (const char*)g.A + (size_t)cur.pm * tstep; const char* cB = (const char*)g.Bt + (size_t)cur.pn * tstep;
    S.a_ready(cur);
    if constexpr (SP2) {
        PG8_STAGE(PG8_SB(0, 0), cB, voffB); PG8_STAGE(PG8_SB(0, 1), cB + hstep, voffB); PG8_STAGE(PG8_SA(0, 0), cA, voffA); PG8_STAGE(PG8_SA(0, 1), cA + hstep, voffA);
        if (wr == 1) PG8_BAR;
        PG8_WAIT_V(2); PG8_BAR;
        PG8_STAGE(PG8_SB(1, 0), cB + kstep, voffB); PG8_STAGE(PG8_SA(1, 0), cA + kstep, voffA); PG8_STAGE(PG8_SB(1, 1), cB + hstep + kstep, voffB);
        PG8_WAIT_V(6); PG8_BAR;
    } else {
        PG8_STAGE(PG8_SB(0, 0), cB, voffB); PG8_STAGE(PG8_SA(0, 0), cA, voffA); PG8_STAGE(PG8_SB(0, 1), cB + hstep, voffB); PG8_STAGE(PG8_SA(0, 1), cA + hstep, voffA);
        if (wr == 1) PG8_BAR;
        PG8_WAIT_V(4); PG8_BAR;
        PG8_STAGE(PG8_SB(1, 0), cB + kstep, voffB); PG8_STAGE(PG8_SA(1, 0), cA + kstep, voffA); PG8_STAGE(PG8_SB(1, 1), cB + hstep + kstep, voffB);
        PG8_WAIT_V(6); PG8_BAR;
    }
    for (;;) {
        const bool has_next = S.next(ui + 1, nxt);
        const char* nA = has_next ? (const char*)g.A + (size_t)nxt.pm * tstep : cA; const char* nB = has_next ? (const char*)g.Bt + (size_t)nxt.pn * tstep : cB;
        for (int t = 0; t < nt; t += 2) {
            const bool last = (t == nt - 2);
            const char* a1 = cA + (size_t)(t + 1) * kstep;
            const char* a2 = last ? nA : cA + (size_t)(t + 2) * kstep; const char* b2 = last ? nB : cB + (size_t)(t + 2) * kstep;
            const char* a3 = a2 + kstep; const char* b3 = b2 + kstep;
            if (last && has_next) S.a_ready(nxt);
            if constexpr (SP2) {
            PG8_LDB(B0, 0, 0); PG8_LDB(B1, 0, 1); PG8_SCHED; PG8_LDA(At, 0, 0); PG8_STAGE(PG8_SA(1, 1), a1 + hstep, voffA);
            PG8_WAIT_V(8); PG8_WAIT_L(0); PG8_BAR; PG8_MMA(0, 0, At, B0); PG8_MMA(0, 1, At, B1); PG8_BAR; PG8_SCHED;
            PG8_LDA(At, 0, 1); PG8_STAGE(PG8_SB(0, 0), b2, voffB); PG8_STAGE(PG8_SB(0, 1), b2 + hstep, voffB); PG8_STAGE(PG8_SA(0, 0), a2, voffA);
            PG8_WAIT_V(8); PG8_WAIT_L(0); PG8_BAR; PG8_MMA(1, 0, At, B0); PG8_MMA(1, 1, At, B1); PG8_BAR; PG8_SCHED;
            PG8_LDB(B0, 1, 0); PG8_LDB(B1, 1, 1); PG8_SCHED; PG8_LDA(At, 1, 0); PG8_STAGE(PG8_SA(0, 1), a2 + hstep, voffA);
            PG8_WAIT_V(8); PG8_WAIT_L(0); PG8_BAR; PG8_MMA(0, 0, At, B0); PG8_MMA(0, 1, At, B1); PG8_BAR; PG8_SCHED;
            PG8_LDA(At, 1, 1); PG8_STAGE(PG8_SB(1, 0), b3, voffB); PG8_STAGE(PG8_SB(1, 1), b3 + hstep, voffB); PG8_STAGE(PG8_SA(1, 0), a3, voffA);
            PG8_WAIT_V(8); PG8_WAIT_L(0); PG8_BAR; PG8_MMA(1, 0, At, B0); PG8_MMA(1, 1, At, B1); PG8_BAR; PG8_SCHED;
            } else {
            PG8_LDB(B0, 0, 0); PG8_SCHED; PG8_LDA(At, 0, 0); PG8_STAGE(PG8_SA(1, 1), a1 + hstep, voffA);
            PG8_WAIT_L(8); PG8_BAR; PG8_WAIT_L(0); PG8_MMA(0, 0, At, B0); PG8_BAR; PG8_SCHED;
            PG8_LDB(B1, 0, 1); PG8_STAGE(PG8_SB(0, 0), b2, voffB);
            PG8_BAR; PG8_WAIT_L(0); PG8_MMA(0, 1, At, B1); PG8_BAR;
            PG8_LDA(At, 0, 1); PG8_STAGE(PG8_SA(0, 0), a2, voffA);
            PG8_BAR; PG8_WAIT_L(0); PG8_MMA(1, 0, At, B0); PG8_BAR; PG8_SCHED;
            PG8_STAGE(PG8_SB(0, 1), b2 + hstep, voffB);
            PG8_WAIT_V(6); PG8_BAR; PG8_MMA(1, 1, At, B1); PG8_BAR;
            PG8_LDB(B0, 1, 0); PG8_SCHED; PG8_LDA(At, 1, 0); PG8_STAGE(PG8_SA(0, 1), a2 + hstep, voffA);
            PG8_WAIT_L(8); PG8_BAR; PG8_WAIT_L(0); PG8_MMA(0, 0, At, B0); PG8_BAR; PG8_SCHED;
            PG8_LDB(B1, 1, 1); PG8_STAGE(PG8_SB(1, 0), b3, voffB);
            PG8_BAR; PG8_WAIT_L(0); PG8_MMA(0, 1, At, B1); PG8_BAR;
            PG8_LDA(At, 1, 1); PG8_STAGE(PG8_SA(1, 0), a3, voffA);
            PG8_BAR; PG8_WAIT_L(0); PG8_MMA(1, 0, At, B0); PG8_BAR; PG8_SCHED;
            PG8_STAGE(PG8_SB(1, 1), b3 + hstep, voffB);
            PG8_WAIT_V(6); PG8_BAR; PG8_MMA(1, 1, At, B1); PG8_BAR;
            }
        }
        if constexpr (ALIGN_EPI) { if (wr == 0) PG8_BAR; }
        if constexpr (!Epi::AFTER_DRAIN) { E(acc, cur, wr, wc, fr, fq); S.done(cur); }
        if (!has_next) break;
#pragma unroll
        for (int a = 0; a < 2; ++a)
#pragma unroll
            for (int b = 0; b < 2; ++b)
#pragma unroll
                for (int m = 0; m < 4; ++m)
#pragma unroll
                    for (int n = 0; n < 2; ++n) acc[a][b][m][n] = (f32x4){0.f, 0.f, 0.f, 0.f};
        cur = nxt; cA = nA; cB = nB; ++ui;
        if constexpr (ALIGN_EPI) { if (wr == 1) PG8_BAR; }
    }
    PG8_WAIT_V(0);
    if constexpr (!ALIGN_EPI) { if (wr == 0) PG8_BAR; }
    PG8_BAR;
    if constexpr (Epi::AFTER_DRAIN) { E.fused(acc, cur, wr, wc, fr, fq, lds, wid, lane); S.done(cur); }
#undef PG8_SA
#undef PG8_SB
#undef PG8_STAGE
#undef PG8_LDA
#undef PG8_LDB
#undef PG8_MMA
#undef PG8_WAIT_V
#undef PG8_WAIT_L
#undef PG8_BAR
#undef PG8_SCHED
}
}

#define LAS __attribute__((address_space(3)))
typedef unsigned short bf16;
typedef float f32x4 __attribute__((ext_vector_type(4)));
typedef float f32x2 __attribute__((ext_vector_type(2)));
typedef unsigned u32x4 __attribute__((ext_vector_type(4)));
typedef unsigned u32x2 __attribute__((ext_vector_type(2)));
typedef short bf16x8 __attribute__((ext_vector_type(8)));

constexpr int NB = 16, SEQ = 2048, D = 2048, T = NB * SEQ, DFF = 5632, NMOD = 9 * D;
constexpr int NPROJ = 5120, NIN = 5128, NIN_PAD = 5376, NGU = 2 * DFF;
constexpr float EPS = 1e-6f;
constexpr size_t MiB = 1u << 20;
constexpr size_t OFF_H0A = 256 * 1024, OFF_H0 = 512 * 1024, OFF_S00 = 768 * 1024;
constexpr size_t OFF_GX = 2304 * 1024, OFF_UX = 2688 * 1024, OFF_YP = 3072 * 1024;
constexpr size_t OFF_MOD = 1 * MiB, OFF_YSSQ = 4 * MiB, OFF_GVSTAT = 8 * MiB, OFF_HSSQ = 12 * MiB, OFF_G = 14 * MiB;
constexpr size_t OFF_WGU0 = 16 * MiB, OFF_WD0 = 60 * MiB, OFF_WGU1 = 82 * MiB, OFF_WD1 = 126 * MiB, OFF_WIN = 148 * MiB, OFF_WOUT = 169 * MiB;
constexpr size_t OFF_H = 192 * MiB, OFF_Y = 320 * MiB, OFF_ACT = 448 * MiB, WS_END = 800 * MiB;
constexpr int LDS_BYTES = 155648;
constexpr int LDP = 136;

__device__ __forceinline__ unsigned short f2bf(float f) { unsigned u = __float_as_uint(f); return (unsigned short)((u + 0x7fffu + ((u >> 16) & 1u)) >> 16); }
__device__ __forceinline__ unsigned pk2(float lo, float hi) { return pg8::cvt_pk_bf16(lo, hi); }
__device__ __forceinline__ float bflo(unsigned w) { return __uint_as_float(w << 16); }
__device__ __forceinline__ float bfhi(unsigned w) { return __uint_as_float(w & 0xffff0000u); }
__device__ __forceinline__ float wave_sum(float v) {
#pragma unroll
    for (int o = 1; o < 64; o <<= 1) v += __shfl_xor(v, o);
    return v;
}
#define LDS_WAIT() asm volatile("s_waitcnt lgkmcnt(0)" ::: "memory")
__device__ __forceinline__ bf16x8 frag(const LAS unsigned char* base, int row, int kcol) { return *(const LAS bf16x8*)(base + (row * LDP + kcol) * 2); }
#define MFMA16(a, b, c) __builtin_amdgcn_mfma_f32_16x16x32_bf16((a), (b), (c), 0, 0, 0)

__device__ __forceinline__ void transpose_item(const float* __restrict__ W, int N, int k0, int src4, bf16* __restrict__ WT, int K, int dstrow0, LAS float* scr, int lane) {
    const int lr = lane >> 4, c4 = lane & 15;
#pragma unroll
    for (int i = 0; i < 16; ++i) { const int kk = 4 * i + lr;
        const f32x4 v = src4 >= 0 ? __builtin_nontemporal_load((const f32x4*)(W + (size_t)(k0 + kk) * N + src4)) : (f32x4){0.f, 0.f, 0.f, 0.f};
        LAS float* d = scr + kk * 65 + 4 * c4; d[0] = v[0]; d[1] = v[1]; d[2] = v[2]; d[3] = v[3]; }
    LDS_WAIT();
    const int c = lane & 7;
#pragma unroll
    for (int j = 0; j < 8; ++j) { const int n = (lane >> 3) + 8 * j; const LAS float* sp = scr + (8 * c) * 65 + n;
        u32x4 o; o.x = pk2(sp[0 * 65], sp[1 * 65]); o.y = pk2(sp[2 * 65], sp[3 * 65]); o.z = pk2(sp[4 * 65], sp[5 * 65]); o.w = pk2(sp[6 * 65], sp[7 * 65]);
        *(u32x4*)(WT + (size_t)(dstrow0 + n) * K + k0 + 8 * c) = o; }
    LDS_WAIT();
}
__device__ __forceinline__ void p0_transposes(const float* const* in, unsigned char* ws, LAS unsigned char* lds, int blk, int nblk, int wid, int lane) {
    LAS float* scr = (LAS float*)(lds + wid * 16640);
    constexpr int IT_FF = 32 * 88, IT_IN = 32 * (NIN_PAD / 64), IT_OUT = 32 * 32, NITEMS = 6 * IT_FF + IT_IN + IT_OUT;
    int ibeg, iend;
    if (nblk == 256) { constexpr int N1 = 70, BASE = 144 * N1, REM = NITEMS - BASE;
        if (blk < 144) { ibeg = blk * N1; iend = ibeg + N1; } else { ibeg = BASE + (int)(((long)(blk - 144) * REM) / 112); iend = BASE + (int)(((long)(blk - 143) * REM) / 112); } }
    else { ibeg = (int)(((long)blk * NITEMS) / nblk); iend = (int)(((long)(blk + 1) * NITEMS) / nblk); }
    const int c4 = 4 * (lane & 15);
    for (int it = ibeg + wid; it < iend; it += 8) {
        if (it < 6 * IT_FF) {
            const int mat = it / IT_FF, r = it - mat * IT_FF, f = mat / 3, kind = mat - 3 * f;
            bf16* wgu = (bf16*)(ws + (f ? OFF_WGU1 : OFF_WGU0)); bf16* wd = (bf16*)(ws + (f ? OFF_WD1 : OFF_WD0));
            if (kind < 2) {
                const float* W = (kind == 0 ? in[6] : in[7]) + (size_t)f * D * DFF;
                const int kb = r / 88, nb = r - kb * 88, n0 = 64 * nb;
                transpose_item(W, DFF, 64 * kb, n0 + c4, wgu, D, 256 * (n0 >> 7) + (n0 & 127) + 128 * kind, scr, lane);
            } else {
                const float* W = in[8] + (size_t)f * DFF * D;
                const int kb = r >> 5, nb = r & 31;
                transpose_item(W, D, 64 * kb, 64 * nb + c4, wd, DFF, 64 * nb, scr, lane);
            }
        } else {
            int r = it - 6 * IT_FF;
            if (r < IT_IN) {
                const int nblk2 = NIN_PAD / 64, kb = r / nblk2, nb = r - kb * nblk2, d = 64 * nb + c4;
                const int src = d < 3072 ? d : (d < 5120 ? d + 8 : (d < 5128 ? d - 2048 : -1));
                transpose_item(in[9], NIN, 64 * kb, src, (bf16*)(ws + OFF_WIN), D, 64 * nb, scr, lane);
            } else {
                r -= IT_IN; const int kb = r >> 5, nb = r & 31;
                transpose_item(in[19], D, 64 * kb, 64 * nb + c4, (bf16*)(ws + OFF_WOUT), D, 64 * nb, scr, lane);
            }
        }
    }
}
template <int MODE, int CPL, int UNR>
__device__ __forceinline__ void gemv16_item(const float* __restrict__ A, const float* __restrict__ Bv, int lda, const float* __restrict__ W, int ldw, int n0, int cbeg, int cend,
                                            const float* __restrict__ bias, float* __restrict__ out, int ldo, LAS unsigned char* lds, int tid, int wid, int lane) {
    typedef float vt __attribute__((ext_vector_type(CPL)));
    constexpr int NC = 64 * CPL;
    LAS float* sw = (LAS float*)(lds + wid * 4096);
    LAS float* red = (LAS float*)(lds + 32768);
    vt acc[16];
#pragma unroll
    for (int b = 0; b < 16; ++b) acc[b] = (vt)(0.f);
    for (int c = cbeg + wid; c < cend; c += 8) {
        const int k0 = c * 64;
#pragma unroll
        for (int b = 0; b < 16; ++b) { const float v = A[(size_t)b * lda + k0 + lane]; float f;
            if (MODE == 0) f = v / (1.0f + __expf(-v)); else if (MODE == 1) f = v; else f = v / (1.0f + expf(-v)) * Bv[(size_t)b * lda + k0 + lane];
            sw[lane * 16 + b] = f; }
        LDS_WAIT();
#pragma unroll UNR
        for (int kk = 0; kk < 64; ++kk) {
            const vt wv = __builtin_nontemporal_load((const vt*)(W + (size_t)(k0 + kk) * ldw + n0 + CPL * lane));
            const LAS f32x4* sp = (const LAS f32x4*)(sw + kk * 16);
            const f32x4 s0 = sp[0], s1 = sp[1], s2 = sp[2], s3 = sp[3];
            acc[0] += wv * s0[0]; acc[1] += wv * s0[1]; acc[2] += wv * s0[2]; acc[3] += wv * s0[3];
            acc[4] += wv * s1[0]; acc[5] += wv * s1[1]; acc[6] += wv * s1[2]; acc[7] += wv * s1[3];
            acc[8] += wv * s2[0]; acc[9] += wv * s2[1]; acc[10] += wv * s2[2]; acc[11] += wv * s2[3];
            acc[12] += wv * s3[0]; acc[13] += wv * s3[1]; acc[14] += wv * s3[2]; acc[15] += wv * s3[3];
        }
        LDS_WAIT();
    }
#pragma unroll
    for (int b = 0; b < 16; ++b) *(LAS vt*)(red + (wid * 16 + b) * NC + CPL * lane) = acc[b];
    __syncthreads();
#pragma unroll
    for (int i = 0; i < 2 * CPL; ++i) { const int o = tid + 512 * i, b = o / NC, n = o % NC; float sacc = bias ? bias[n0 + n] : 0.f;
#pragma unroll
        for (int w = 0; w < 8; ++w) sacc += red[(w * 16 + b) * NC + n];
        out[(size_t)b * ldo + n0 + n] = sacc; }
    __syncthreads();
}

#ifndef EXACT_FFN0
#define EXACT_FFN0 0
#endif
__device__ __forceinline__ void row_pass(int k, const float* __restrict__ x, float* out, const bf16* __restrict__ Y, const float* __restrict__ yssq, const float* __restrict__ mod,
                                         const float* __restrict__ g_pre, const float* __restrict__ g_post, bf16* __restrict__ H, float* __restrict__ H0, float* __restrict__ H0A, const float* __restrict__ YP, LAS unsigned char* lds, int wid, int gw, int NGW, int lane) {
    int rbeg, rend, rstep;
    if ((NGW % NB) == 0 && (SEQ % (NGW / NB)) == 0) { const int wpb = NGW / NB, b0 = gw / wpb, wl = gw - b0 * wpb; rbeg = b0 * SEQ + wl; rend = (b0 + 1) * SEQ; rstep = wpb; }
    else { const int rpw = (T + NGW - 1) / NGW; rbeg = gw * rpw; rend = (rbeg + rpw < T) ? rbeg + rpw : T; rstep = 1; }
    if (rbeg >= rend) return;
    LAS f32x4* AVL = (LAS f32x4*)(lds + wid * 16384); LAS f32x4* SHL = (LAS f32x4*)(lds + wid * 16384 + 8192);
    const float* xin_base = (k <= 1) ? x : out;
    const int jj = k - 1;
    const float coef = (jj == 1) ? 1.0f : 0.5f;
    int cur_b = -1;
    f32x4 cg[8];
    f32x4 xn[8]; u32x2 yn[8]; float pn = 0.f;
#pragma unroll
    for (int i = 0; i < 8; ++i) { cg[i] = (f32x4){0.f, 0.f, 0.f, 0.f}; yn[i] = (u32x2){0u, 0u}; }
#define RP_LOAD(r_) do { _Pragma("unroll") for (int i = 0; i < 8; ++i) { const int d_ = 4 * (lane + 64 * i); \
        xn[i] = __builtin_nontemporal_load((const f32x4*)(xin_base + (size_t)(r_) * D + d_)); if (k > 0) yn[i] = __builtin_nontemporal_load((const u32x2*)(Y + (size_t)(r_) * D + d_)); } \
        if (k > 0) pn = lane < 32 ? yssq[(size_t)(r_) * 32 + lane] : 0.f; } while (0)
    RP_LOAD(rbeg);
    for (int r = rbeg; r < rend; r += rstep) {
        f32x4 xv[8]; u32x2 yw[8]; float p = pn;
#pragma unroll
        for (int i = 0; i < 8; ++i) { xv[i] = xn[i]; yw[i] = yn[i]; }
        if (r + rstep < rend) RP_LOAD(r + rstep);
        const int b = r >> 11;
        if (b != cur_b) {
            cur_b = b;
#pragma unroll
            for (int i = 0; i < 8; ++i) { const int d = 4 * (lane + 64 * i);
                if (k > 0) { const f32x4 gt = *(const f32x4*)(mod + (size_t)b * NMOD + (jj * 3 + 2) * D + d); const f32x4 gp = *(const f32x4*)(g_post + jj * D + d); cg[i] = gt * gp * coef; }
                if (k < 3) { const f32x4 gp = *(const f32x4*)(g_pre + k * D + d); const f32x4 sc = *(const f32x4*)(mod + (size_t)b * NMOD + (k * 3 + 1) * D + d);
                    AVL[lane + 64 * i] = gp * (sc + 1.0f); SHL[lane + 64 * i] = *(const f32x4*)(mod + (size_t)b * NMOD + (k * 3 + 0) * D + d); } }
            LDS_WAIT();
        }
        float ss = 0.f;
        if (EXACT_FFN0 && k == 1 && (r & (SEQ - 1)) == 0) {
            f32x4 ye[8]; float pe = 0.f;
#pragma unroll
            for (int i = 0; i < 8; ++i) { const int d = 4 * (lane + 64 * i); const float* yp = YP + (size_t)b * D + d;
                ye[i] = ((*(const f32x4*)yp + *(const f32x4*)(yp + 16 * D)) + (*(const f32x4*)(yp + 32 * D) + *(const f32x4*)(yp + 48 * D)))
                      + ((*(const f32x4*)(yp + 64 * D) + *(const f32x4*)(yp + 80 * D)) + (*(const f32x4*)(yp + 96 * D) + *(const f32x4*)(yp + 112 * D)));
                pe += (ye[i][0] * ye[i][0] + ye[i][1] * ye[i][1]) + (ye[i][2] * ye[i][2] + ye[i][3] * ye[i][3]); }
            pe = wave_sum(pe); const float rstd_y = 1.0f / sqrtf(pe * (1.0f / D) + EPS);
#pragma unroll
            for (int i = 0; i < 8; ++i) { const int d = 4 * (lane + 64 * i);
                const f32x4 v = xv[i] + cg[i] * rstd_y * ye[i];
                __builtin_nontemporal_store(v, (f32x4*)(out + (size_t)r * D + d)); xv[i] = v; }
        } else if (k > 0) {
            p = wave_sum(p); const float rstd_y = 1.0f / sqrtf(p * (1.0f / D) + EPS);
#pragma unroll
            for (int i = 0; i < 8; ++i) { const int d = 4 * (lane + 64 * i);
                f32x4 v = xv[i]; const f32x4 c = cg[i] * rstd_y;
                v[0] += c[0] * bflo(yw[i].x); v[1] += c[1] * bfhi(yw[i].x); v[2] += c[2] * bflo(yw[i].y); v[3] += c[3] * bfhi(yw[i].y);
                __builtin_nontemporal_store(v, (f32x4*)(out + (size_t)r * D + d)); xv[i] = v; }
        }
        if (k < 3) {
#pragma unroll
            for (int i = 0; i < 8; ++i) { const f32x4 v = xv[i]; ss += (v[0] * v[0] + v[1] * v[1]) + (v[2] * v[2] + v[3] * v[3]); }
            ss = wave_sum(ss);
            const float rstd = 1.0f / sqrtf(ss * (1.0f / D) + EPS);
            const bool keep = (k == 1 || (EXACT_FFN0 && k == 0)) && ((r & (SEQ - 1)) == 0);
#pragma unroll
            for (int i = 0; i < 8; ++i) { const int d = 4 * (lane + 64 * i);
                const f32x4 hf = xv[i] * rstd * AVL[lane + 64 * i] + SHL[lane + 64 * i];
                u32x2 o; o.x = pk2(hf[0], hf[1]); o.y = pk2(hf[2], hf[3]);
                *(u32x2*)(H + (size_t)r * D + d) = o;
                if (keep) *(f32x4*)((k == 0 ? H0A : H0) + (size_t)b * D + d) = hf; }
        }
    }
#undef RP_LOAD
}

__device__ __forceinline__ void gate_unit(int pm, const bf16* __restrict__ H, const bf16* __restrict__ Wg, const float* __restrict__ b_i, const float* __restrict__ b_f, float* __restrict__ G, int w, int lane) {
    const int fr = lane & 15, fq = lane >> 4;
    const bf16* a0 = H + (size_t)(pm * 256 + 32 * w + fr) * D + 8 * fq;
    const bf16* a1 = a0 + (size_t)16 * D;
    const bf16* bp = Wg + (size_t)(fr & 7) * D + 8 * fq;
    f32x4 acc0 = (f32x4){0.f, 0.f, 0.f, 0.f}, acc1 = acc0;
#pragma unroll 8
    for (int ks = 0; ks < 64; ++ks) {
        const bf16x8 bv = *(const bf16x8*)(bp + 32 * ks), x0 = *(const bf16x8*)(a0 + 32 * ks), x1 = *(const bf16x8*)(a1 + 32 * ks);
        acc0 = MFMA16(bv, x0, acc0); acc1 = MFMA16(bv, x1, acc1);
    }
    if (fq < 2) {
        const f32x4 bias = fq == 0 ? *(const f32x4*)b_i : *(const f32x4*)b_f;
        *(f32x4*)(G + (size_t)(pm * 256 + 32 * w + fr) * 8 + 4 * fq) = acc0 + bias;
        *(f32x4*)(G + (size_t)(pm * 256 + 32 * w + 16 + fr) * 8 + 4 * fq) = acc1 + bias;
    }
}
__device__ __forceinline__ void s00_task(int b, int h, const float* __restrict__ H0, const float* __restrict__ w_in, const float* __restrict__ conv_w, const float* __restrict__ conv_b,
                                         float* __restrict__ S00, LAS unsigned char* lds, int tid, int wid, int lane) {
    LAS float* red = (LAS float*)lds;
    LAS float* qk = (LAS float*)(lds + 8192);
    const int col = (lane < 32) ? (128 * h + 4 * lane) : (512 + 128 * h + 4 * (lane - 32));
    const float* hp = H0 + (size_t)b * D + wid * 256;
    const float* wp = w_in + (size_t)(wid * 256) * NIN + col;
    f32x4 acc = (f32x4){0.f, 0.f, 0.f, 0.f};
#pragma unroll 32
    for (int k = 0; k < 256; ++k) { const float hv = hp[k]; const f32x4 wv = *(const f32x4*)(wp + (size_t)k * NIN); acc += wv * hv; }
    *(LAS f32x4*)(red + wid * 256 + 4 * lane) = acc;
    __syncthreads();
    if (tid < 256) {
        float p = 0.f;
#pragma unroll
        for (int w8 = 0; w8 < 8; ++w8) p += red[w8 * 256 + tid];
        const int ch = (tid < 128) ? (128 * h + tid) : (512 + 128 * h + (tid - 128));
        float y = conv_w[3 * 1024 + ch] * p + conv_b[ch];
        y = y / (1.0f + expf(-y));
        if (tid >= 128) y *= 0.08838834764831845f;
        qk[tid] = y;
    }
    __syncthreads();
    if (wid == 0) { float v = qk[lane] * qk[128 + lane] + qk[64 + lane] * qk[192 + lane]; v = wave_sum(v); if (lane == 0) S00[b * 4 + h] = v; }
    __syncthreads();
}

constexpr int ML_QS = 0, ML_KS = 34816, ML_KT = 69632, ML_VT = 104448, ML_CB = 126208, ML_GA = 147968, ML_GB = ML_GA + 512, ML_IS = ML_GB + 512, ML_EMT = ML_IS + 512,
              ML_WL = ML_EMT + 512, ML_TMP = ML_WL + 512, ML_SC = ML_TMP + 512;
static_assert(ML_SC + 64 <= LDS_BYTES, "LDS map");
__device__ __forceinline__ float scan_add(float v, int lane) {
#pragma unroll
    for (int o = 1; o < 64; o <<= 1) { const float t = __shfl_up(v, o); if (lane >= o) v += t; }
    return v;
}
__device__ __forceinline__ float scan_max(float v, int lane) {
#pragma unroll
    for (int o = 1; o < 64; o <<= 1) { const float t = __shfl_up(v, o); if (lane >= o) v = fmaxf(v, t); }
    return v;
}
__device__ __forceinline__ float logsig(float v) { return fminf(v, 0.f) - log1pf(expf(-fabsf(v))); }
__device__ __forceinline__ void mlstm_item(int b, int h, int sl, const bf16* __restrict__ PROJ, const float* __restrict__ G, const float* __restrict__ conv_w, const float* __restrict__ conv_b,
                                           bf16* __restrict__ MIX, float* __restrict__ HSSQ, const float* __restrict__ S00, LAS unsigned char* lds, int tid, int w, int lane) {
    const int fr = lane & 15, fq = lane >> 4;
    LAS bf16* QS = (LAS bf16*)(lds + ML_QS); LAS bf16* KS = (LAS bf16*)(lds + ML_KS); LAS bf16* KT = (LAS bf16*)(lds + ML_KT);
    LAS bf16* VT = (LAS bf16*)(lds + ML_VT); LAS bf16* CB = (LAS bf16*)(lds + ML_CB);
    LAS float* GA = (LAS float*)(lds + ML_GA); LAS float* GB = (LAS float*)(lds + ML_GB); LAS float* IS = (LAS float*)(lds + ML_IS);
    LAS float* EMT = (LAS float*)(lds + ML_EMT); LAS float* WL = (LAS float*)(lds + ML_WL); LAS float* SC = (LAS float*)(lds + ML_SC);
    f32x4 st[5];
#pragma unroll
    for (int e = 0; e < 5; ++e) st[e] = (f32x4){0.f, 0.f, 0.f, 0.f};
    float m_prev = 0.f;
    for (int i = tid; i < 80 * LDP / 2; i += 512) ((LAS unsigned*)CB)[i] = 0u;
    for (int i = tid; i < 16 * LDP; i += 512) VT[64 * LDP + i] = (i < LDP) ? (bf16)0x3F80 : (bf16)0;
    __syncthreads();
    const int cgi = tid & 31, isk = cgi >> 4, cg8 = cgi & 15, t0 = 8 * (tid >> 5);
    const int colp = isk * 512 + h * 128 + 8 * cg8;
    u32x4 raw[11]; u32x4 vraw[2]; float gpre[4] = {0.f, 0.f, 0.f, 0.f};
#define ML_LOAD(c_) do { const int rl_ = b * SEQ + (c_) * 128; \
        _Pragma("unroll") for (int i = 0; i < 11; ++i) { const int tt = t0 - 3 + i; \
            raw[i] = ((c_) > 0 || tt >= 0) ? *(const u32x4*)(PROJ + (size_t)(rl_ + tt) * NPROJ + colp) : (u32x4){0u, 0u, 0u, 0u}; } \
        _Pragma("unroll") for (int i = 0; i < 2; ++i) { const int idx = tid + 512 * i; \
            vraw[i] = *(const u32x4*)(PROJ + (size_t)(rl_ + (idx >> 3)) * NPROJ + 1024 + h * 256 + sl * 64 + 8 * (idx & 7)); } \
        if (w == 0) { gpre[0] = G[(size_t)(rl_ + lane) * 8 + h]; gpre[1] = G[(size_t)(rl_ + lane) * 8 + 4 + h]; \
                      gpre[2] = G[(size_t)(rl_ + 64 + lane) * 8 + h]; gpre[3] = G[(size_t)(rl_ + 64 + lane) * 8 + 4 + h]; } } while (0)
    ML_LOAD(0);
    for (int c = 0; c < 16; ++c) {
        const int r0 = b * SEQ + c * 128;
        if (w == 0) {
            const float ig1 = gpre[0], fg1 = gpre[1], ig2 = gpre[2], fg2 = gpre[3];
            const float bc1 = scan_add(logsig(fg1), lane); const float tot1 = __shfl(bc1, 63);
            const float bc2 = scan_add(logsig(fg2), lane) + tot1;
            const float ga1 = ig1 - bc1, ga2 = ig2 - bc2;
            const float pm1 = scan_max(ga1, lane); const float pmt = __shfl(pm1, 63);
            const float pm2 = fmaxf(scan_max(ga2, lane), pmt);
            const float b_last = __shfl(bc2, 63), amax = __shfl(pm2, 63);
            const float m_loc = b_last + amax, m_new = fmaxf(b_last + m_prev, m_loc), s_fac = expf(m_loc - m_new);
            { const float m_inter = bc1 + m_prev, m_t = fmaxf(m_inter, bc1 + pm1);
              IS[lane] = expf(m_inter - m_t); GB[lane] = bc1 - m_t; EMT[lane] = expf(-m_t); GA[lane] = ga1; WL[lane] = s_fac * expf(ga1 - amax); }
            { const float m_inter = bc2 + m_prev, m_t = fmaxf(m_inter, bc2 + pm2);
              IS[64 + lane] = expf(m_inter - m_t); GB[64 + lane] = bc2 - m_t; EMT[64 + lane] = expf(-m_t); GA[64 + lane] = ga2; WL[64 + lane] = s_fac * expf(ga2 - amax); }
            if (lane == 63) { SC[0] = b_last; SC[1] = amax; }
        }
#pragma unroll
        for (int i = 0; i < 2; ++i) {
            const int idx = tid + 512 * i, s = idx >> 3, eg = idx & 7; const u32x4 rv = vraw[i];
            LAS bf16* vp = VT + (8 * eg) * LDP + s;
            vp[0 * LDP] = (bf16)(rv.x & 0xffffu); vp[1 * LDP] = (bf16)(rv.x >> 16); vp[2 * LDP] = (bf16)(rv.y & 0xffffu); vp[3 * LDP] = (bf16)(rv.y >> 16);
            vp[4 * LDP] = (bf16)(rv.z & 0xffffu); vp[5 * LDP] = (bf16)(rv.z >> 16); vp[6 * LDP] = (bf16)(rv.w & 0xffffu); vp[7 * LDP] = (bf16)(rv.w >> 16);
        }
        __syncthreads();
        const float b_last = SC[0], amax = SC[1];
        const float m_loc = b_last + amax, m_new = fmaxf(b_last + m_prev, m_loc);
        const float a_fac = expf(b_last + m_prev - m_new);
        {
            f32x4 wl0 = (f32x4){0.f, 0.f, 0.f, 0.f}, wl1 = wl0;
            if (isk) { wl0 = *(const LAS f32x4*)(WL + t0); wl1 = *(const LAS f32x4*)(WL + t0 + 4); }
            const float scl = isk ? 0.08838834764831845f : 1.0f;
            LAS bf16* dst = (isk ? KS : QS) + t0 * LDP + 8 * cg8;
            int colw = colp; asm volatile("" : "+v"(colw));
#pragma unroll
            for (int ep = 0; ep < 4; ++ep) {
                float xl[11], xh[11];
#pragma unroll
                for (int i = 0; i < 11; ++i) { const unsigned wd = raw[i][ep]; xl[i] = bflo(wd); xh[i] = bfhi(wd); }
                f32x2 wj[4];
#pragma unroll
                for (int j = 0; j < 4; ++j) wj[j] = *(const f32x2*)(conv_w + j * 1024 + colw + 2 * ep);
                const f32x2 bb = *(const f32x2*)(conv_b + colw + 2 * ep);
                float yl[8], yh[8];
#pragma unroll
                for (int o = 0; o < 8; ++o) {
                    float a0 = bb.x, a1 = bb.y;
#pragma unroll
                    for (int j = 0; j < 4; ++j) { a0 += wj[j].x * xl[o + j]; a1 += wj[j].y * xh[o + j]; }
                    yl[o] = pg8::silu_f(a0) * scl; yh[o] = pg8::silu_f(a1) * scl;
                    *(LAS unsigned*)(dst + o * LDP + 2 * ep) = pk2(yl[o], yh[o]);
                }
                if (isk) {
                    u32x4 k0, k1;
                    k0.x = pk2(yl[0] * wl0[0], yl[1] * wl0[1]); k0.y = pk2(yl[2] * wl0[2], yl[3] * wl0[3]); k0.z = pk2(yl[4] * wl1[0], yl[5] * wl1[1]); k0.w = pk2(yl[6] * wl1[2], yl[7] * wl1[3]);
                    k1.x = pk2(yh[0] * wl0[0], yh[1] * wl0[1]); k1.y = pk2(yh[2] * wl0[2], yh[3] * wl0[3]); k1.z = pk2(yh[4] * wl1[0], yh[5] * wl1[1]); k1.w = pk2(yh[6] * wl1[2], yh[7] * wl1[3]);
                    *(LAS u32x4*)(KT + (8 * cg8 + 2 * ep) * LDP + t0) = k0;
                    *(LAS u32x4*)(KT + (8 * cg8 + 2 * ep + 1) * LDP + t0) = k1;
                }
            }
        }
        if (c + 1 < 16) ML_LOAD(c + 1);
        __syncthreads();
        f32x4 S[8];
#pragma unroll
        for (int s8 = 0; s8 < 8; ++s8) S[s8] = (f32x4){0.f, 0.f, 0.f, 0.f};
#pragma unroll 1
        for (int ks = 0; ks < 4; ++ks) {
            const bf16x8 a = frag(lds + ML_QS, 16 * w + fr, 32 * ks + 8 * fq);
#pragma unroll
            for (int s8 = 0; s8 < 8; ++s8) if (s8 <= w) { const bf16x8 bk = frag(lds + ML_KS, 16 * s8 + fr, 32 * ks + 8 * fq); S[s8] = MFMA16(bk, a, S[s8]); }
        }
        if (c == 0 && tid == 0) S[0][0] = S00[b * 4 + h];
        __syncthreads();
        {
            const int t = 16 * w + fr; const float gb = GB[t];
#pragma unroll
            for (int s8 = 0; s8 < 8; ++s8) {
                const f32x4 ga4 = *(const LAS f32x4*)(GA + 16 * s8 + 4 * fq);
                float pv[4];
#pragma unroll
                for (int j = 0; j < 4; ++j) { const int s = 16 * s8 + 4 * fq + j; pv[j] = (s8 <= w && s <= t) ? S[s8][j] * __expf(gb + ga4[j]) : 0.f; }
                u32x2 o; o.x = pk2(pv[0], pv[1]); o.y = pk2(pv[2], pv[3]);
                *(LAS u32x2*)(KS + t * LDP + 16 * s8 + 4 * fq) = o;
            }
        }
        __syncthreads();
        {
            f32x4 a1[5], a2[5];
#pragma unroll
            for (int e = 0; e < 5; ++e) { a1[e] = (f32x4){0.f, 0.f, 0.f, 0.f}; a2[e] = (f32x4){0.f, 0.f, 0.f, 0.f}; }
#pragma unroll 1
            for (int ks = 0; ks < 4; ++ks) {
                const bf16x8 ap = frag(lds + ML_KS, 16 * w + fr, 32 * ks + 8 * fq), aq = frag(lds + ML_QS, 16 * w + fr, 32 * ks + 8 * fq);
#pragma unroll
                for (int e = 0; e < 5; ++e) {
                    const bf16x8 bv = frag(lds + ML_VT, 16 * e + fr, 32 * ks + 8 * fq), bcb = frag(lds + ML_CB, 16 * e + fr, 32 * ks + 8 * fq);
                    a1[e] = MFMA16(bv, ap, a1[e]); a2[e] = MFMA16(bcb, aq, a2[e]);
                }
            }
            const int t = 16 * w + fr; const float isv = IS[t], emt = EMT[t];
            const float den0 = isv * a2[4][0] + a1[4][0];
            const float den = __shfl(den0, fr);
            const float inv = 1.0f / fmaxf(fabsf(den), emt);
            float ssq = 0.f;
            bf16* op = MIX + (size_t)(r0 + t) * D + h * 256 + sl * 64 + 4 * fq;
#pragma unroll
            for (int e = 0; e < 4; ++e) {
                const float h0 = (isv * a2[e][0] + a1[e][0]) * inv, h1 = (isv * a2[e][1] + a1[e][1]) * inv, h2 = (isv * a2[e][2] + a1[e][2]) * inv, h3 = (isv * a2[e][3] + a1[e][3]) * inv;
                ssq += (h0 * h0 + h1 * h1) + (h2 * h2 + h3 * h3);
                u32x2 o; o.x = pk2(h0, h1); o.y = pk2(h2, h3);
                *(u32x2*)(op + 16 * e) = o;
            }
            ssq += __shfl_xor(ssq, 16); ssq += __shfl_xor(ssq, 32);
            if (fq == 0) HSSQ[(size_t)(r0 + t) * 16 + 4 * h + sl] = ssq;
        }
        __syncthreads();
#pragma unroll
        for (int e = 0; e < 5; ++e) st[e] = st[e] * a_fac;
#pragma unroll
        for (int ks = 0; ks < 4; ++ks) {
            const bf16x8 bk = frag(lds + ML_KT, 16 * w + fr, 32 * ks + 8 * fq);
#pragma unroll
            for (int e = 0; e < 5; ++e) { const bf16x8 av = frag(lds + ML_VT, 16 * e + fr, 32 * ks + 8 * fq); st[e] = MFMA16(bk, av, st[e]); }
        }
#pragma unroll
        for (int e = 0; e < 5; ++e) { u32x2 o; o.x = pk2(st[e][0], st[e][1]); o.y = pk2(st[e][2], st[e][3]);
            *(LAS u32x2*)(CB + (16 * e + fr) * LDP + 16 * w + 4 * fq) = o; }
        m_prev = m_new;
        __syncthreads();
    }
}

constexpr int SG_WS = 0, SG_VP = 34816, SG_MU = 69632, SG_RS = SG_MU + 512;
__device__ __forceinline__ bool sg_item_of(int q, int blk, int nblk, int& g, int& r0) {
    int pair;
    if ((nblk % 8) == 0) { g = blk & 7; pair = (blk >> 3) + (nblk >> 3) * q; if (pair >= 256) return false; }
    else { const int it = blk + nblk * q; if (it >= 8 * 256) return false; g = it & 7; pair = it >> 3; }
    r0 = (pair >> 4) * SEQ + (pair & 15) * 128; return true;
}
__device__ __forceinline__ void sg_items(int blk, int nblk, const bf16* __restrict__ PROJ, const float* __restrict__ gvstat, const float* __restrict__ ln_g, const float* __restrict__ ln_b,
                                         const float* __restrict__ w_sp, const float* __restrict__ b_sp, bf16* __restrict__ MIX, LAS unsigned char* lds, int tid, int w, int lane) {
    const int fr = lane & 15, fq = lane >> 4;
    LAS bf16* WS = (LAS bf16*)(lds + SG_WS); LAS bf16* VP = (LAS bf16*)(lds + SG_VP); LAS float* MU = (LAS float*)(lds + SG_MU); LAS float* RS = (LAS float*)(lds + SG_RS);
    int cur_g = -1, g, r0;
    if (!sg_item_of(0, blk, nblk, g, r0)) return;
    f32x4 stn[2]; u32x4 rawn[4]; u32x2 uwn[8];
#define SG_LOAD(g_, r0_) do { \
        const f32x4* gp_ = (const f32x4*)(gvstat + (size_t)((r0_) + (tid >> 2)) * 32) + 2 * (tid & 3); stn[0] = gp_[0]; stn[1] = gp_[1]; \
        _Pragma("unroll") for (int i = 0; i < 4; ++i) { const int idx = tid + 512 * i; rawn[i] = *(const u32x4*)(PROJ + (size_t)((r0_) + (idx >> 4)) * NPROJ + 4096 + 128 * (g_) + 8 * (idx & 15)); } \
        const bf16* up_ = PROJ + (size_t)((r0_) + 16 * w + fr) * NPROJ + 3072 + 128 * (g_) + 4 * fq; \
        _Pragma("unroll") for (int ct = 0; ct < 8; ++ct) uwn[ct] = *(const u32x2*)(up_ + 16 * ct); } while (0)
    SG_LOAD(g, r0);
    for (int q = 0;; ++q) {
        if (g != cur_g) {
            __syncthreads();
            for (int idx = tid; idx < 128 * 32; idx += 512) { const int t = idx >> 5, s0 = 4 * (idx & 31);
                f32x4 v = *(const f32x4*)(w_sp + (size_t)(g * 128 + t) * 128 + s0);
                u32x2 o; o.x = pk2(s0 <= t ? v[0] : 0.f, s0 + 1 <= t ? v[1] : 0.f); o.y = pk2(s0 + 2 <= t ? v[2] : 0.f, s0 + 3 <= t ? v[3] : 0.f);
                *(LAS u32x2*)(WS + t * LDP + s0) = o; }
            cur_g = g;
        }
        {
            float s1 = (stn[0][0] + stn[0][2]) + (stn[1][0] + stn[1][2]), s2 = (stn[0][1] + stn[0][3]) + (stn[1][1] + stn[1][3]);
            s1 += __shfl_xor(s1, 1); s2 += __shfl_xor(s2, 1); s1 += __shfl_xor(s1, 2); s2 += __shfl_xor(s2, 2);
            const float mean = s1 * (1.0f / 1024.0f), var = fmaxf(s2 * (1.0f / 1024.0f) - mean * mean, 0.f);
            if ((tid & 3) == 0) { MU[tid >> 2] = mean; RS[tid >> 2] = 1.0f / sqrtf(var + EPS); }
        }
        u32x2 uw[8];
#pragma unroll
        for (int ct = 0; ct < 8; ++ct) uw[ct] = uwn[ct];
        __syncthreads();
#pragma unroll
        for (int i = 0; i < 4; ++i) {
            const int idx = tid + 512 * i, s = idx >> 4, cg8 = idx & 15, ch = 128 * g + 8 * cg8;
            const u32x4 raw = rawn[i];
            const f32x4 g0 = *(const f32x4*)(ln_g + ch), g1 = *(const f32x4*)(ln_g + ch + 4), c0 = *(const f32x4*)(ln_b + ch), c1 = *(const f32x4*)(ln_b + ch + 4);
            const float mu = MU[s], rs = RS[s];
            LAS bf16* vp = VP + (8 * cg8) * LDP + s;
            vp[0 * LDP] = f2bf((bflo(raw.x) - mu) * rs * g0[0] + c0[0]); vp[1 * LDP] = f2bf((bfhi(raw.x) - mu) * rs * g0[1] + c0[1]);
            vp[2 * LDP] = f2bf((bflo(raw.y) - mu) * rs * g0[2] + c0[2]); vp[3 * LDP] = f2bf((bfhi(raw.y) - mu) * rs * g0[3] + c0[3]);
            vp[4 * LDP] = f2bf((bflo(raw.z) - mu) * rs * g1[0] + c1[0]); vp[5 * LDP] = f2bf((bfhi(raw.z) - mu) * rs * g1[1] + c1[1]);
            vp[6 * LDP] = f2bf((bflo(raw.w) - mu) * rs * g1[2] + c1[2]); vp[7 * LDP] = f2bf((bfhi(raw.w) - mu) * rs * g1[3] + c1[3]);
        }
        const int gc = g, rc = r0;
        const bool more = sg_item_of(q + 1, blk, nblk, g, r0);
        if (more) SG_LOAD(g, r0);
        __syncthreads();
        f32x4 z[8];
#pragma unroll
        for (int ct = 0; ct < 8; ++ct) z[ct] = (f32x4){0.f, 0.f, 0.f, 0.f};
#pragma unroll
        for (int ks = 0; ks < 4; ++ks) {
            const bf16x8 a = frag(lds + SG_WS, 16 * w + fr, 32 * ks + 8 * fq);
#pragma unroll
            for (int ct = 0; ct < 8; ++ct) { const bf16x8 bv = frag(lds + SG_VP, 16 * ct + fr, 32 * ks + 8 * fq); z[ct] = MFMA16(bv, a, z[ct]); }
        }
        const int t = 16 * w + fr; const float bs = b_sp[gc * 128 + t];
        bf16* op = MIX + (size_t)(rc + t) * D + 1024 + 128 * gc + 4 * fq;
#pragma unroll
        for (int ct = 0; ct < 8; ++ct) {
            u32x2 o; o.x = pk2(bflo(uw[ct].x) * (z[ct][0] + bs), bfhi(uw[ct].x) * (z[ct][1] + bs)); o.y = pk2(bflo(uw[ct].y) * (z[ct][2] + bs), bfhi(uw[ct].y) * (z[ct][3] + bs));
            *(u32x2*)(op + 16 * ct) = o;
        }
        if (!more) break;
        __syncthreads();
    }
#undef SG_LOAD
}
__device__ __forceinline__ void headnorm_pass(bf16* MIX, const bf16* __restrict__ PROJ, const float* __restrict__ HSSQ, const float* __restrict__ g_mh, int gw, int NGW, int lane) {
    f32x4 g0[2], g1[2];
#pragma unroll
    for (int i = 0; i < 2; ++i) { const int col = 8 * lane + 512 * i; g0[i] = *(const f32x4*)(g_mh + col); g1[i] = *(const f32x4*)(g_mh + col + 4); }
    for (int r0 = gw; r0 < T; r0 += 4 * NGW) {
        u32x4 hv[4][2], ov[4][2]; f32x4 q[4][2];
#pragma unroll
        for (int j = 0; j < 4; ++j) { const int r = r0 + j * NGW; if (r < T) {
#pragma unroll
            for (int i = 0; i < 2; ++i) { const int col = 8 * lane + 512 * i, hd = col >> 8;
                q[j][i] = *(const f32x4*)(HSSQ + (size_t)r * 16 + 4 * hd);
                hv[j][i] = *(const u32x4*)(MIX + (size_t)r * D + col);
                ov[j][i] = __builtin_nontemporal_load((const u32x4*)(PROJ + (size_t)r * NPROJ + 2048 + col)); } } }
#pragma unroll
        for (int j = 0; j < 4; ++j) { const int r = r0 + j * NGW; if (r < T) {
#pragma unroll
            for (int i = 0; i < 2; ++i) { const int col = 8 * lane + 512 * i;
                const float rstd = 1.0f / sqrtf(((q[j][i][0] + q[j][i][1]) + (q[j][i][2] + q[j][i][3])) * (1.0f / 256.0f) + EPS);
                const u32x4 h = hv[j][i], o4 = ov[j][i]; const f32x4 ga = g0[i] * rstd, gb = g1[i] * rstd;
                u32x4 o;
                o.x = pk2(bflo(h.x) * ga[0] * bflo(o4.x), bfhi(h.x) * ga[1] * bfhi(o4.x));
                o.y = pk2(bflo(h.y) * ga[2] * bflo(o4.y), bfhi(h.y) * ga[3] * bfhi(o4.y));
                o.z = pk2(bflo(h.z) * gb[0] * bflo(o4.z), bfhi(h.z) * gb[1] * bfhi(o4.z));
                o.w = pk2(bflo(h.w) * gb[2] * bflo(o4.w), bfhi(h.w) * gb[3] * bfhi(o4.w));
                *(u32x4*)(MIX + (size_t)r * D + col) = o; } } }
    }
}

#define XB_TMO      128
#define XB_XCNT(j)  (256  + 64 * (j))
#define XB_XSUB(j)  (1280 + 64 * (j))
#define XB_XGEN(j)  (2304 + 64 * (j))
#define XB_TOP      3328
#define XB_TOPGEN   3392
#define XCD_BAR_WORDS 3456
#define XB_SPIN_CAP (1u << 18)

__device__ __forceinline__ unsigned xb_ld(unsigned* p)              { return __hip_atomic_load(p, __ATOMIC_RELAXED, __HIP_MEMORY_SCOPE_AGENT); }
__device__ __forceinline__ unsigned xb_add(unsigned* p, unsigned v) { return __hip_atomic_fetch_add(p, v, __ATOMIC_RELAXED, __HIP_MEMORY_SCOPE_AGENT); }
__device__ __forceinline__ unsigned xb_xcc_id() { return (unsigned)__builtin_amdgcn_s_getreg((3 << 11) | 20) & 0xFu; }
#define XB_SPIN(cond, bar) do { unsigned _sp = 0; while (cond) { __builtin_amdgcn_s_sleep(1); \
    if ((++_sp & 255u) == 0u) { if (xb_ld(&(bar)[XB_TMO])) break; if (_sp > XB_SPIN_CAP) { atomicAdd(&(bar)[XB_TMO], 1u); break; } } } } while (0)

struct XcdBarrier {
    unsigned* bar; unsigned x;
    volatile LAS unsigned* st;
};

__device__ __forceinline__ XcdBarrier xcd_barrier_post(unsigned* bar, volatile LAS unsigned* st) {
    XcdBarrier b; b.bar = bar; b.x = xb_xcc_id(); b.st = st;
    if (threadIdx.x == 0) (void)xb_add(&bar[XB_XCNT(b.x)], 1u);
    return b;
}
__device__ __forceinline__ void xcd_barrier_complete(unsigned* bar, unsigned x, unsigned& nloc, unsigned& nx) {
    const unsigned G = gridDim.x * gridDim.y * gridDim.z;
    unsigned sum, cnt, mine, sp = 0u;
    for (;;) {
        sum = 0u; cnt = 0u; mine = 0u;
#pragma unroll
        for (unsigned j = 0; j < 16; ++j) { const unsigned c = xb_ld(&bar[XB_XCNT(j)]); sum += c; cnt += (c > 0u) ? 1u : 0u; mine = (j == x) ? c : mine; }
        if (sum == G) break;
        __builtin_amdgcn_s_sleep(1);
        if ((++sp & 255u) == 0u) { if (xb_ld(&bar[XB_TMO])) break; if (sp > XB_SPIN_CAP) { atomicAdd(&bar[XB_TMO], 1u); break; } }
    }
    nloc = mine > 0u ? mine : 1u; nx = cnt > 0u ? cnt : 1u;
}

__device__ __forceinline__ void xcd_barrier(const XcdBarrier& b) {
    asm volatile("s_waitcnt vmcnt(0)" ::: "memory");
    __syncthreads();
    if (threadIdx.x == 0) {
        unsigned* bar = b.bar;
        __builtin_amdgcn_s_waitcnt(0);
        unsigned nloc = b.st[0], nx = b.st[1];
        if (nloc == 0u) { xcd_barrier_complete(bar, b.x, nloc, nx); b.st[0] = nloc; b.st[1] = nx; }
        const unsigned old = xb_add(&bar[XB_XSUB(b.x)], 1u);
        const unsigned gen = old / nloc;
        if (old + 1u == (gen + 1u) * nloc) {
            __builtin_amdgcn_fence(__ATOMIC_RELEASE, "agent");
            asm volatile("s_waitcnt vmcnt(0)" ::: "memory");
            const unsigned og = xb_add(&bar[XB_TOP], 1u);
            const unsigned tg = og / nx;
            if (og + 1u == (tg + 1u) * nx) xb_add(&bar[XB_TOPGEN], 1u);
            else XB_SPIN(xb_ld(&bar[XB_TOPGEN]) == tg, bar);
            __builtin_amdgcn_fence(__ATOMIC_ACQUIRE, "agent");
            xb_add(&bar[XB_XGEN(b.x)], 1u);
            asm volatile("s_waitcnt vmcnt(0)" ::: "memory");
        } else {
            XB_SPIN(xb_ld(&bar[XB_XGEN(b.x)]) == gen, bar);
            __builtin_amdgcn_fence(__ATOMIC_ACQUIRE, "agent");
            asm volatile("s_waitcnt vmcnt(0)" ::: "memory");
        }
    }
    __syncthreads();
}

struct Args { const float* in[20]; float* out; unsigned char* ws; };
#ifndef GEMM_REPS
#define GEMM_REPS 1
#endif
#define REPLOOP _Pragma("unroll 1") for (int rep_ = 0; rep_ < GEMM_REPS; ++rep_)
__global__ void __launch_bounds__(512, 2) mega_fwd(Args a) {
    extern __shared__ __attribute__((aligned(16))) unsigned char lds_raw[];
    cg::grid_group grid = cg::this_grid();
    LAS unsigned char* lds = (LAS unsigned char*)lds_raw;
    const int blk = blockIdx.x, G_ = gridDim.x, NGW = G_ * 8;
#define FRESH() int tid = threadIdx.x; asm volatile("" : "+v"(tid)); const int lane = tid & 63, wid = __builtin_amdgcn_readfirstlane(tid >> 6), gw = blk * 8 + wid; (void)lane; (void)gw;
    unsigned char* ws = a.ws;
    float* MOD = (float*)(ws + OFF_MOD); float* YSSQ = (float*)(ws + OFF_YSSQ); float* GVSTAT = (float*)(ws + OFF_GVSTAT); float* HSSQ = (float*)(ws + OFF_HSSQ); float* GT = (float*)(ws + OFF_G);
    float* H0 = (float*)(ws + OFF_H0); float* S00 = (float*)(ws + OFF_S00); float* H0A = (float*)(ws + OFF_H0A);
    float* GX = (float*)(ws + OFF_GX); float* UX = (float*)(ws + OFF_UX); float* YP = (float*)(ws + OFF_YP);
    bf16* Hb = (bf16*)(ws + OFF_H); bf16* Yb = (bf16*)(ws + OFF_Y); bf16* ACT = (bf16*)(ws + OFF_ACT);
    const float* x = a.in[0];
    unsigned* BARW = (unsigned*)ws;
    volatile LAS unsigned* BST = (volatile LAS unsigned*)(lds + LDS_BYTES - 64);
    if (threadIdx.x < 2) BST[threadIdx.x] = 0u;
    if (blk == 0) { for (int i = threadIdx.x; i < XCD_BAR_WORDS; i += 512) __hip_atomic_store(BARW + i, 0u, __ATOMIC_RELAXED, __HIP_MEMORY_SCOPE_AGENT); }

#ifndef NO_P0
    { FRESH();
    if (blk < 144) gemv16_item<0, 2, 8>(a.in[1], nullptr, D, a.in[2], NMOD, 128 * blk, 0, 32, a.in[3], MOD, NMOD, lds, tid, wid, lane);
    else if (G_ < 144) { for (int it = blk; it < 144; it += G_) gemv16_item<0, 2, 8>(a.in[1], nullptr, D, a.in[2], NMOD, 128 * it, 0, 32, a.in[3], MOD, NMOD, lds, tid, wid, lane); }
    p0_transposes(a.in, ws, lds, blk, G_, wid, lane); }
#endif
    grid.sync();
    XcdBarrier xbar = xcd_barrier_post(BARW, BST);
#define GSYNC() xcd_barrier(xbar)
#pragma unroll 1
    for (int k = 0; k < 3; ++k) {
#ifndef NO_ROW
        { FRESH(); row_pass(k, x, a.out, Yb, YSSQ, MOD, a.in[4], a.in[5], Hb, H0, H0A, YP, lds, wid, gw, NGW, lane); }
#endif
        GSYNC();
        if (k != 1) {
            const int f = k >> 1;
#ifndef NO_G1
            { pg8::Gemm g{Hb, (const bf16*)(ws + (f ? OFF_WGU1 : OFF_WGU0)), T, NGU, D}; pg8::StaticOrder S; S.init(T, NGU, G_, blk);
              pg8::EpiSwiglu E{ACT, DFF};
              REPLOOP pg8::gemm_phase<pg8::EpiSwiglu, pg8::StaticOrder, true, true>(lds, g, S, E); }
#endif
            if (EXACT_FFN0 && f == 0) { FRESH(); for (int it = blk; it < 176; it += G_) { const int up = it >= 88, nb = up ? it - 88 : it;
                gemv16_item<1, 1, 64>(H0A, nullptr, D, (up ? a.in[7] : a.in[6]), DFF, 64 * nb, 0, 32, nullptr, up ? UX : GX, DFF, lds, tid, wid, lane); } }
            GSYNC();
#ifndef NO_G2
            { pg8::Gemm g{ACT, (const bf16*)(ws + (f ? OFF_WD1 : OFF_WD0)), T, D, DFF}; pg8::StaticOrder S; S.init(T, D, G_, blk);
              pg8::EpiYStat E{Yb, D, YSSQ};
              REPLOOP pg8::gemm_phase<pg8::EpiYStat, pg8::StaticOrder, true, true>(lds, g, S, E); }
#endif
            if (EXACT_FFN0 && f == 0) { FRESH(); for (int it = G_ - 1 - blk; it < 128; it += G_) { const int q8 = it >> 4, nb = it & 15;
                gemv16_item<2, 2, 32>(GX, UX, DFF, a.in[8], D, 128 * nb, 11 * q8, 11 * q8 + 11, nullptr, YP + (size_t)q8 * 16 * D, D, lds, tid, wid, lane); } }
            GSYNC();
        } else {
#ifndef NO_G3
            { pg8::Gemm g{Hb, (const bf16*)(ws + OFF_WIN), T, NPROJ, D}; pg8::StaticOrder S; S.init(T, NPROJ, G_, blk);
              pg8::EpiProj E{ACT, NPROJ, GVSTAT, GT, a.in[12], a.in[13]};
              REPLOOP pg8::gemm_phase<pg8::EpiProj, pg8::StaticOrder, true, true>(lds, g, S, E); }
#endif
            { FRESH(); for (int u = blk; u < T / 256; u += G_) gate_unit(u, Hb, (const bf16*)(ws + OFF_WIN) + (size_t)NPROJ * D, a.in[12], a.in[13], GT, wid, lane); }
            { FRESH(); for (int task = G_ - 1 - blk; task < 64; task += G_) s00_task(task >> 2, task & 3, H0, a.in[9], a.in[10], a.in[11], S00, lds, tid, wid, lane); }
            GSYNC();
#ifndef NO_ML
#ifndef MIX_REPS
#define MIX_REPS 1
#endif
            _Pragma("unroll 1") for (int mrep = 0; mrep < MIX_REPS; ++mrep) {
            { FRESH(); for (int it = blk; it < 256; it += G_) mlstm_item(it >> 4, (it >> 2) & 3, it & 3, ACT, GT, a.in[10], a.in[11], Hb, HSSQ, S00, lds, tid, wid, lane); }
#endif
#ifndef NO_SG
            { FRESH(); sg_items(blk, G_, ACT, GVSTAT, a.in[15], a.in[16], a.in[17], a.in[18], Hb, lds, tid, wid, lane); }
#endif
            }
            GSYNC();
#ifndef NO_HN
            { FRESH(); headnorm_pass(Hb, ACT, HSSQ, a.in[14], gw, NGW, lane); }
#endif
            GSYNC();
#ifndef NO_G4
            { pg8::Gemm g{Hb, (const bf16*)(ws + OFF_WOUT), T, D, D}; pg8::StaticOrder S; S.init(T, D, G_, blk);
              pg8::EpiYStat E{Yb, D, YSSQ};
              REPLOOP pg8::gemm_phase<pg8::EpiYStat, pg8::StaticOrder, true, true>(lds, g, S, E); }
#endif
            GSYNC();
        }
    }
    { FRESH(); row_pass(3, x, a.out, Yb, YSSQ, MOD, a.in[4], a.in[5], Hb, H0, H0A, YP, lds, wid, gw, NGW, lane); }
}

extern "C" void kernel_launch(void* const* d_in, const int* in_sizes, int n_in, void* d_out, int out_size, void* d_ws, size_t ws_size, hipStream_t stream) {
    static int grid = 0;
    if (grid == 0) {
        if (n_in != 20 || out_size != T * D || ws_size < WS_END) { fprintf(stderr, "kernel_launch: unexpected shapes (n_in %d out %d ws %zu)\n", n_in, out_size, ws_size); grid = -1; return; }
        int dev = 0, cus = 0, per_cu = 0;
        hipGetDevice(&dev); hipDeviceGetAttribute(&cus, hipDeviceAttributeMultiprocessorCount, dev);
        if (hipFuncSetAttribute((const void*)mega_fwd, hipFuncAttributeMaxDynamicSharedMemorySize, LDS_BYTES) != hipSuccess) { fprintf(stderr, "kernel_launch: hipFuncSetAttribute failed\n"); grid = -1; return; }
        if (hipOccupancyMaxActiveBlocksPerMultiprocessor(&per_cu, (const void*)mega_fwd, 512, LDS_BYTES) != hipSuccess || per_cu < 1) { fprintf(stderr, "kernel_launch: occupancy query says %d\n", per_cu); per_cu = 1; }
        (void)hipGetLastError();
        grid = cus * per_cu;
        if (grid < 144) { fprintf(stderr, "kernel_launch: grid %d < 144 workgroups is not supported\n", grid); grid = -1; return; }
        fprintf(stderr, "kernel_launch: grid %d (cus %d x %d)\n", grid, cus, per_cu);
    }
    if (grid < 0) return;
    Args a{};
    for (int i = 0; i < 20; ++i) a.in[i] = (const float*)d_in[i];
    a.out = (float*)d_out; a.ws = (unsigned char*)d_ws;
    void* args[] = {&a};
    hipError_t e = hipLaunchCooperativeKernel((const void*)mega_fwd, dim3(grid), dim3(512), args, LDS_BYTES, stream);
    if (e != hipSuccess) fprintf(stderr, "cooperative launch failed: %s (grid %d)\n", hipGetErrorString(e), grid);
}
```
